# Optimizing an MI355X kernel written in HIP

```python
import jax, jax.numpy as jnp
from jax import lax
import numpy as np

D_MODEL = 1024
BATCH = 8
SEQ = 2048
DEPTH = 1
DEC_BATCH = 8
DEC_SEQ = 8192
PAST_LEN = 128

GRID_W = 64
Q_BLOCK = 128
ROPE_THETA = 10000.0
NORM_EPS = 1e-6
GQA_HEADS = 8
GQA_KV_HEADS = 2
GQA_HEAD_DIM = 64
MLA_HEADS = 8
MLA_Q_RANK = 256
MLA_KV_RANK = 128
MLA_NOPE_DIM = 64
MLA_ROPE_DIM = 32
MLA_V_DIM = 64
GQA_WIDTH = GQA_HEADS * GQA_HEAD_DIM
MLA_WIDTH = MLA_HEADS * MLA_V_DIM
MIX_WIDTH = GQA_WIDTH + MLA_WIDTH
IN_SPLITS = (GQA_WIDTH, GQA_KV_HEADS * GQA_HEAD_DIM, GQA_KV_HEADS * GQA_HEAD_DIM, MLA_Q_RANK, MLA_KV_RANK, MLA_ROPE_DIM)
IN_WIDTH = sum(IN_SPLITS)
D_FF = -(-8 * D_MODEL // (3 * 256)) * 256

kernel_name = 'hymba_gqa_mla_deepnorm_adaln_encoder'


def _rms_norm(x, g):
    xf = x.astype(jnp.float32)
    y = xf * lax.rsqrt(jnp.mean(xf * xf, axis=-1, keepdims=True) + NORM_EPS)
    return (y * g.astype(jnp.float32)).astype(x.dtype)


def _layer_norm(x, g=None, b=None):
    xf = x.astype(jnp.float32)
    xc = xf - jnp.mean(xf, axis=-1, keepdims=True)
    y = xc * lax.rsqrt(jnp.mean(xc * xc, axis=-1, keepdims=True) + NORM_EPS)
    if g is not None:
        y = y * g.astype(jnp.float32) + b.astype(jnp.float32)
    return y.astype(x.dtype)


def _axial_rope(seq_len, rot_dim):
    rows = seq_len // GRID_W
    row = jnp.repeat(jnp.arange(rows, dtype=jnp.float32), GRID_W)
    col = jnp.tile(jnp.arange(GRID_W, dtype=jnp.float32), rows)
    n = rot_dim // 4
    inv_freq = 1.0 / jnp.power(ROPE_THETA, jnp.arange(n, dtype=jnp.float32) / n)
    ang = jnp.concatenate([row[:, None] * inv_freq, col[:, None] * inv_freq], axis=-1)
    return jnp.cos(ang), jnp.sin(ang)


def _apply_rope(x, cos, sin):
    xf = x.astype(jnp.float32)
    half = x.shape[-1] // 2
    x1, x2 = xf[..., :half], xf[..., half:]
    c = cos[None, :, None, :]
    s = sin[None, :, None, :]
    return jnp.concatenate([x1 * c - x2 * s, x1 * s + x2 * c], axis=-1).astype(x.dtype)


def _block_attention(q, k, v, scale):
    B, S, KV, G, dq = q.shape
    dv = v.shape[-1]
    nb = S // Q_BLOCK
    qb = q.reshape(B, nb, Q_BLOCK, KV, G, dq).transpose(1, 0, 2, 3, 4, 5)

    def one_block(q_blk):
        s = jnp.einsum('bqkgd,bskd->bkgqs', q_blk, k).astype(jnp.float32) * scale
        p = jax.nn.softmax(s, axis=-1).astype(v.dtype)
        return jnp.einsum('bkgqs,bskd->bqkgd', p, v)

    o = lax.map(one_block, qb)
    return o.transpose(1, 0, 2, 3, 4, 5).reshape(B, S, KV * G * dv)


def _encoder_layer(x, c, rope_a, rope_b, w_ada, b_ada, w_in, gqa_q_norm, gqa_k_norm,
                   mla_q_norm, w_uq, mla_kv_norm, w_ukv, grp_norm_a, grp_norm_b, w_out,
                   ln1_g, ln1_b, w_gate, w_up, w_down, ln2_g, ln2_b):
    B, S, _ = x.shape
    alpha = (2.0 * DEPTH) ** 0.25
    mod = jax.nn.silu(c) @ w_ada + b_ada
    sh1, sc1, g1, sh2, sc2, g2 = [m[:, None, :] for m in jnp.split(mod, 6, axis=-1)]

    u = _layer_norm(x) * (1 + sc1) + sh1
    h = u @ w_in
    offs = [int(o) for o in np.cumsum(IN_SPLITS)[:-1]]
    q_a, k_a, v_a, q_lat, kv_lat, k_rope = jnp.split(h, offs, axis=-1)

    q_a = _apply_rope(_rms_norm(q_a.reshape(B, S, GQA_HEADS, GQA_HEAD_DIM), gqa_q_norm), *rope_a)
    k_a = _apply_rope(_rms_norm(k_a.reshape(B, S, GQA_KV_HEADS, GQA_HEAD_DIM), gqa_k_norm), *rope_a)
    v_a = v_a.reshape(B, S, GQA_KV_HEADS, GQA_HEAD_DIM)
    q_a = q_a.reshape(B, S, GQA_KV_HEADS, GQA_HEADS // GQA_KV_HEADS, GQA_HEAD_DIM)
    o_a = _block_attention(q_a, k_a, v_a, GQA_HEAD_DIM ** -0.5)

    q_m = (_rms_norm(q_lat, mla_q_norm) @ w_uq).reshape(B, S, MLA_HEADS, MLA_NOPE_DIM + MLA_ROPE_DIM)
    q_nope = q_m[..., :MLA_NOPE_DIM]
    q_pe = _apply_rope(q_m[..., MLA_NOPE_DIM:], *rope_b)
    kv = (_rms_norm(kv_lat, mla_kv_norm) @ w_ukv).reshape(B, S, MLA_HEADS, MLA_NOPE_DIM + MLA_V_DIM)
    k_nope, v_m = kv[..., :MLA_NOPE_DIM], kv[..., MLA_NOPE_DIM:]
    k_pe = _apply_rope(k_rope[:, :, None, :], *rope_b)
    k_m = jnp.concatenate([k_nope, jnp.broadcast_to(k_pe, (B, S, MLA_HEADS, MLA_ROPE_DIM))], axis=-1)
    q_m = jnp.concatenate([q_nope, q_pe], axis=-1)[:, :, :, None, :]
    o_m = _block_attention(q_m, k_m, v_m, (MLA_NOPE_DIM + MLA_ROPE_DIM) ** -0.5)

    mix = jnp.concatenate([_rms_norm(o_a, grp_norm_a), _rms_norm(o_m, grp_norm_b)], axis=-1) @ w_out
    x = _layer_norm(alpha * x + g1 * mix, ln1_g, ln1_b)

    u2 = _layer_norm(x) * (1 + sc2) + sh2
    f = (jax.nn.silu(u2 @ w_gate) * (u2 @ w_up)) @ w_down
    return _layer_norm(alpha * x + g2 * f, ln2_g, ln2_b)


def _trunk(x, c, params):
    S = x.shape[1]
    rope_a = _axial_rope(S, GQA_HEAD_DIM)
    rope_b = _axial_rope(S, MLA_ROPE_DIM)
    for l in range(DEPTH):
        x = _encoder_layer(x, c, rope_a, rope_b, *[p[l] for p in params])
    return x


def setup_inputs(seed: int = 0) -> dict:
    key = jax.random.key(seed)
    ks = jax.random.split(key, 24)
    beta = (8.0 * DEPTH) ** -0.25

    def dense(k, shape, fan_in, mult=1.0):
        return jax.random.normal(k, shape, jnp.float32) * (fan_in ** -0.5) * mult

    def gain(k, n):
        return 1.0 + 0.1 * jax.random.normal(k, (DEPTH, n), jnp.float32)

    def bias(k, n):
        return 0.02 * jax.random.normal(k, (DEPTH, n), jnp.float32)

    return {
        'x_prompt': jax.random.normal(ks[0], (BATCH, SEQ, D_MODEL), jnp.float32),
        'x_sample': jax.random.normal(ks[1], (DEC_BATCH, DEC_SEQ, D_MODEL), jnp.float32),
        'c_prompt': jax.random.normal(ks[2], (BATCH, D_MODEL), jnp.float32),
        'c_sample': jax.random.normal(ks[3], (DEC_BATCH, D_MODEL), jnp.float32),
        'w_ada': dense(ks[4], (DEPTH, D_MODEL, 6 * D_MODEL), D_MODEL, 0.5),
        'b_ada': bias(ks[5], 6 * D_MODEL),
        'w_in': dense(ks[6], (DEPTH, D_MODEL, IN_WIDTH), D_MODEL),
        'gqa_q_norm': gain(ks[7], GQA_HEAD_DIM),
        'gqa_k_norm': gain(ks[8], GQA_HEAD_DIM),
        'mla_q_norm': gain(ks[9], MLA_Q_RANK),
        'w_uq': dense(ks[10], (DEPTH, MLA_Q_RANK, MLA_HEADS * (MLA_NOPE_DIM + MLA_ROPE_DIM)), MLA_Q_RANK),
        'mla_kv_norm': gain(ks[11], MLA_KV_RANK),
        'w_ukv': dense(ks[12], (DEPTH, MLA_KV_RANK, MLA_HEADS * (MLA_NOPE_DIM + MLA_V_DIM)), MLA_KV_RANK),
        'grp_norm_a': gain(ks[13], GQA_WIDTH),
        'grp_norm_b': gain(ks[14], MLA_WIDTH),
        'w_out': dense(ks[15], (DEPTH, MIX_WIDTH, D_MODEL), MIX_WIDTH, beta),
        'ln1_g': gain(ks[16], D_MODEL),
        'ln1_b': bias(ks[17], D_MODEL),
        'w_gate': dense(ks[18], (DEPTH, D_MODEL, D_FF), D_MODEL),
        'w_up': dense(ks[19], (DEPTH, D_MODEL, D_FF), D_MODEL),
        'w_down': dense(ks[20], (DEPTH, D_FF, D_MODEL), D_FF, beta),
        'ln2_g': gain(ks[21], D_MODEL),
        'ln2_b': bias(ks[22], D_MODEL),
    }


def reference(x_prompt, x_sample, c_prompt, c_sample, w_ada, b_ada, w_in, gqa_q_norm, gqa_k_norm,
              mla_q_norm, w_uq, mla_kv_norm, w_ukv, grp_norm_a, grp_norm_b, w_out,
              ln1_g, ln1_b, w_gate, w_up, w_down, ln2_g, ln2_b):
    params = (w_ada, b_ada, w_in, gqa_q_norm, gqa_k_norm, mla_q_norm, w_uq, mla_kv_norm, w_ukv,
              grp_norm_a, grp_norm_b, w_out, ln1_g, ln1_b, w_gate, w_up, w_down, ln2_g, ln2_b)
    y_prompt = _trunk(x_prompt, c_prompt, params)
    y_sample = _trunk(x_sample, c_sample, params)
    return (y_prompt, y_sample)
```

```cpp
#include <hip/hip_runtime.h>
#include <hip/hip_cooperative_groups.h>
#include <cstdio>
#include <cstdint>
namespace cg = cooperative_groups;

typedef unsigned short bf16_t;
typedef short bf16x8 __attribute__((ext_vector_type(8)));
typedef float f32x4 __attribute__((ext_vector_type(4)));
typedef float f32x16 __attribute__((ext_vector_type(16)));
typedef unsigned u32x4 __attribute__((ext_vector_type(4)));
typedef unsigned u32x2 __attribute__((ext_vector_type(2)));
typedef float f32x2_t __attribute__((ext_vector_type(2)));
typedef __bf16 bf16x2_t __attribute__((ext_vector_type(2)));

constexpr int DM = 1024, TP = 8 * 2048, TSMP = 8 * 8192, T = TP + TSMP;
constexpr int HP = 1280;
constexpr int DFF = 2816;
constexpr int NMT = T / 256;
constexpr float EPS = 1e-6f;
constexpr float ALPHA = 1.189207115002721f;
constexpr float LOG2E = 1.4426950408889634f;
constexpr float C2A = 0.125f * LOG2E;
constexpr float C2M = 0.10206207261596575f * LOG2E;

constexpr size_t MiB = 1u << 20;
constexpr size_t WS_W1T = 0;
constexpr size_t WS_WUQT = 3 * MiB;
constexpr size_t WS_WUKVT = 4 * MiB;
constexpr size_t WS_WOUTT = 5 * MiB;
constexpr size_t WS_WGUT = 7 * MiB;
constexpr size_t WS_WDNT = 18 * MiB;
constexpr size_t WS_MOD = 24 * MiB;
constexpr size_t WS_COSA = 25 * MiB;
constexpr size_t WS_SINA = 26 * MiB;
constexpr size_t WS_COSB = 27 * MiB;
constexpr size_t WS_SINB = 28 * MiB;
constexpr size_t WS_RSQ = 29 * MiB;
constexpr size_t WS_RSKV = 30 * MiB;
constexpr size_t WS_BAR = 31 * MiB;
constexpr size_t WS_U = 32 * MiB;
constexpr size_t WS_H = 192 * MiB;
constexpr size_t WS_O = 192 * MiB;
constexpr size_t WS_QA = 392 * MiB;
constexpr size_t WS_KA = 472 * MiB;
constexpr size_t WS_VTA = 492 * MiB;
constexpr size_t WS_QM = 512 * MiB;
constexpr size_t WS_KN = 632 * MiB;
constexpr size_t WS_KPE = 712 * MiB;
constexpr size_t WS_VTM = 717 * MiB;
constexpr size_t WS_F = 192 * MiB;
constexpr size_t WS_PQ = 800 * MiB;
constexpr size_t WS_PKV = 802 * MiB;
constexpr size_t WS_END = 804 * MiB;

constexpr int LDS_XST = 147456;
constexpr int LDS_BYTES = LDS_XST + 256;
constexpr int NPHASE = 12;

struct Params {
    const float* in[23];
    float* out;
    unsigned char* ws;
    int lo, hi;
};

__device__ __forceinline__ unsigned cvtpk(float lo, float hi) { f32x2_t v = {lo, hi}; bf16x2_t b = __builtin_convertvector(v, bf16x2_t); return __builtin_bit_cast(unsigned, b); }
__device__ __forceinline__ bf16_t f2bf(float f) { return (bf16_t)(cvtpk(f, 0.f) & 0xffffu); }
__device__ __forceinline__ float bf2f(unsigned short h) { return __uint_as_float(((unsigned)h) << 16); }
__device__ __forceinline__ float wave_sum(float v) {
#pragma unroll
    for (int o = 32; o >= 1; o >>= 1) v += __shfl_xor(v, o);
    return v;
}
__device__ __forceinline__ void tokinfo(int t, int& b, int& S, int& tok0) {
    if (t < TP) { b = t >> 11; S = 2048; tok0 = b << 11; }
    else { const int u = t - TP; const int bb = u >> 13; b = 8 + bb; S = 8192; tok0 = TP + (bb << 13); }
}
__device__ __forceinline__ const float* xrow(const float* xp, const float* xs, int t) {
    return t < TP ? xp + (size_t)t * DM : xs + (size_t)(t - TP) * DM;
}

constexpr int HTB = 128 * 64 * 2;
__device__ __forceinline__ int lds_byte(int r, int c) {
    const int st = (r >> 4) * 2 + (c >> 5), rr = r & 15, cc = c & 31, ob = rr * 64 + cc * 2;
    return st * 1024 + (ob ^ (((ob >> 9) & 1) << 5));
}
__device__ __forceinline__ void stage_rc(int b, int& R, int& C) {
    const int st = b / 1024, sb = b % 1024, swz = sb ^ (((sb >> 9) & 1) << 5);
    R = (st >> 1) * 16 + swz / 64; C = (st & 1) * 32 + (swz % 64) / 2;
}
__device__ __forceinline__ bool tile_next(int i, int G, int c, int nM, int nN, int& pm, int& pn) {
    const int nwg = nM * nN; const long L = (long)i * G + c; if (L >= nwg) return false;
    int wgid = (int)L;
    if ((G & 7) == 0) { const int q = nwg / 8, r = nwg % 8, xcd = wgid % 8, off = wgid / 8; wgid = (xcd < r ? xcd * (q + 1) : r * (q + 1) + (xcd - r) * q) + off; }
    const int nig = 8 * nN, gid = wgid / nig, fm = gid * 8, gsz = (nM - fm) < 8 ? (nM - fm) : 8;
    pm = fm + ((wgid % nig) % gsz); pn = (wgid % nig) / gsz; return true;
}

#define WAIT_V(n) asm volatile("s_waitcnt vmcnt(" #n ")" ::: "memory")
#define WAIT_L(n) asm volatile("s_waitcnt lgkmcnt(" #n ")" ::: "memory")
#define BAR __builtin_amdgcn_s_barrier()
#define SCHED __builtin_amdgcn_sched_barrier(0)

__device__ __forceinline__ void glds16(const void* sbase, unsigned voff, unsigned ldsdst) {
    unsigned keep;
    asm volatile("s_mov_b32 %0, m0\n\ts_mov_b32 m0, %3\n\ts_nop 0\n\tglobal_load_lds_dwordx4 %2, %1\n\ts_mov_b32 m0, %0"
                 : "=&s"(keep) : "s"(sbase), "v"(voff), "s"(ldsdst) : "memory");
}
template <bool TR>
__device__ __forceinline__ void gemm_core(unsigned char* shm, const bf16_t* __restrict__ A, int lda, const bf16_t* __restrict__ Bt, int ldb,
                                          int nt, int brow, int bcol, f32x4 (&acc)[2][2][4][2]) {
    const int wid = threadIdx.x >> 6, lane = threadIdx.x & 63, wr = wid >> 2, wc = wid & 3, fr = lane & 15, fq = lane >> 4;
    int sr0, sc0; stage_rc(threadIdx.x * 16, sr0, sc0);
    const unsigned offA = (unsigned)(sr0 * lda + sc0) * 2u, offB = (unsigned)(sr0 * ldb + sc0) * 2u;
    const unsigned ldsw = (unsigned)(uintptr_t)shm + (unsigned)__builtin_amdgcn_readfirstlane(wid) * 1024u;
#define SA(b, h) (shm + ((b) * 2 + (h)) * HTB)
#define SB(b, h) (shm + (4 + (b) * 2 + (h)) * HTB)
#define SAO(b, h) (((b) * 2 + (h)) * HTB)
#define SBO(b, h) ((4 + (b) * 2 + (h)) * HTB)
#define STAGE(PO, BASE, LD, VO, br, kt) do { \
        const char* b0_ = (const char*)(BASE) + ((long)(br) * (LD) + (long)(kt) * 64) * 2; \
        glds16(b0_, VO, ldsw + (PO)); glds16(b0_ + (long)(LD) * 128, VO, ldsw + (PO) + 8192u); } while (0)
#define LDA(dst, b, h) for (int m = 0; m < 4; ++m) for (int k = 0; k < 2; ++k) \
        dst[m][k] = *reinterpret_cast<const bf16x8*>(SA(b, h) + lds_byte(wr * 64 + m * 16 + fr, k * 32 + fq * 8))
#define LDB(dst, b, h) for (int n = 0; n < 2; ++n) for (int k = 0; k < 2; ++k) \
        dst[n][k] = *reinterpret_cast<const bf16x8*>(SB(b, h) + lds_byte(wc * 32 + n * 16 + fr, k * 32 + fq * 8))
#define MMA(ai, bj, At_, Bt_) do { __builtin_amdgcn_s_setprio(1); \
        for (int m = 0; m < 4; ++m) for (int n = 0; n < 2; ++n) for (int k = 0; k < 2; ++k) \
            acc[ai][bj][m][n] = TR ? __builtin_amdgcn_mfma_f32_16x16x32_bf16(Bt_[n][k], At_[m][k], acc[ai][bj][m][n], 0, 0, 0) \
                                   : __builtin_amdgcn_mfma_f32_16x16x32_bf16(At_[m][k], Bt_[n][k], acc[ai][bj][m][n], 0, 0, 0); \
        __builtin_amdgcn_s_setprio(0); } while (0)
    bf16x8 At[4][2], B0[2][2], B1[2][2];
#pragma unroll
    for (int a = 0; a < 2; ++a)
#pragma unroll
        for (int b = 0; b < 2; ++b)
#pragma unroll
            for (int m = 0; m < 4; ++m)
#pragma unroll
                for (int n = 0; n < 2; ++n) acc[a][b][m][n] = (f32x4){0.f, 0.f, 0.f, 0.f};
    STAGE(SBO(0, 0), Bt, ldb, offB, bcol, 0); STAGE(SAO(0, 0), A, lda, offA, brow, 0);
    STAGE(SBO(0, 1), Bt, ldb, offB, bcol + 128, 0); STAGE(SAO(0, 1), A, lda, offA, brow + 128, 0);
    if (wr == 1) BAR;
    WAIT_V(4); BAR;
    STAGE(SBO(1, 0), Bt, ldb, offB, bcol, 1); STAGE(SAO(1, 0), A, lda, offA, brow, 1); STAGE(SBO(1, 1), Bt, ldb, offB, bcol + 128, 1);
    WAIT_V(6); BAR;
    for (int t = 0; t < nt - 2; t += 2) {
        LDB(B0, 0, 0); SCHED; LDA(At, 0, 0); STAGE(SAO(1, 1), A, lda, offA, brow + 128, t + 1);
        WAIT_L(8); BAR; WAIT_L(0); MMA(0, 0, At, B0); BAR; SCHED;
        LDB(B1, 0, 1); STAGE(SBO(0, 0), Bt, ldb, offB, bcol, t + 2);
        BAR; WAIT_L(0); MMA(0, 1, At, B1); BAR;
        LDA(At, 0, 1); STAGE(SAO(0, 0), A, lda, offA, brow, t + 2);
        BAR; WAIT_L(0); MMA(1, 0, At, B0); BAR; SCHED;
        STAGE(SBO(0, 1), Bt, ldb, offB, bcol + 128, t + 2);
        WAIT_V(6); BAR; MMA(1, 1, At, B1); BAR;
        LDB(B0, 1, 0); SCHED; LDA(At, 1, 0); STAGE(SAO(0, 1), A, lda, offA, brow + 128, t + 2);
        WAIT_L(8); BAR; WAIT_L(0); MMA(0, 0, At, B0); BAR; SCHED;
        LDB(B1, 1, 1); STAGE(SBO(1, 0), Bt, ldb, offB, bcol, t + 3);
        BAR; WAIT_L(0); MMA(0, 1, At, B1); BAR;
        LDA(At, 1, 1); STAGE(SAO(1, 0), A, lda, offA, brow, t + 3);
        BAR; WAIT_L(0); MMA(1, 0, At, B0); BAR; SCHED;
        STAGE(SBO(1, 1), Bt, ldb, offB, bcol + 128, t + 3);
        WAIT_V(6); BAR; MMA(1, 1, At, B1); BAR;
    }
    { LDB(B0, 0, 0); LDA(At, 0, 0); STAGE(SAO(1, 1), A, lda, offA, brow + 128, nt - 1);
      BAR; WAIT_L(0); MMA(0, 0, At, B0); BAR;
      LDB(B1, 0, 1); BAR; WAIT_L(0); MMA(0, 1, At, B1); BAR;
      LDA(At, 0, 1); WAIT_V(4); BAR; WAIT_L(0); MMA(1, 0, At, B0); MMA(1, 1, At, B1); BAR; }
    { LDB(B0, 1, 0); LDA(At, 1, 0); WAIT_V(2); BAR; WAIT_L(0); MMA(0, 0, At, B0); BAR;
      LDB(B1, 1, 1); WAIT_V(0); BAR; WAIT_L(0); MMA(0, 1, At, B1); BAR;
      LDA(At, 1, 1); BAR; WAIT_L(0); MMA(1, 0, At, B0); MMA(1, 1, At, B1); BAR; }
    if (wr == 0) BAR;
#undef SA
#undef SB
#undef SAO
#undef SBO
#undef STAGE
#undef LDA
#undef LDB
#undef MMA
}

#define EPI_GEOM int tid_e = threadIdx.x; asm volatile("" : "+v"(tid_e)); const int wid = tid_e >> 6, lane = tid_e & 63, wr = wid >> 2, wc = wid & 3, fr = lane & 15, fq = lane >> 4; (void)wr; (void)wc; (void)fr; (void)fq;

__device__ __forceinline__ float dot2ones(unsigned pk, float acc) {
    return __builtin_amdgcn_fdot2_f32_bf16(__builtin_bit_cast(bf16x2_t, pk), __builtin_bit_cast(bf16x2_t, 0x3F803F80u), acc, false);
}
__device__ __forceinline__ int kperm(int i) { return (i & ~12) | ((i & 4) << 1) | ((i & 8) >> 1); }

__device__ __forceinline__ float xmax(float v) {
    auto rr = __builtin_amdgcn_permlane32_swap(__float_as_uint(v), __float_as_uint(v), false, false);
    return fmaxf(__uint_as_float(rr[0]), __uint_as_float(rr[1]));
}
__device__ __forceinline__ float xsum(float v) {
    auto rr = __builtin_amdgcn_permlane32_swap(__float_as_uint(v), __float_as_uint(v), false, false);
    return __uint_as_float(rr[0]) + __uint_as_float(rr[1]);
}
template <int DQ>
__device__ __forceinline__ void attn_unit2(unsigned char* shm, const bf16_t* __restrict__ Q0, const bf16_t* __restrict__ Q1, int ldq,
                                           const bf16_t* __restrict__ K1, int ldk1, const bf16_t* __restrict__ K2, const bf16_t* __restrict__ Vt, int S,
                                           bf16_t* __restrict__ O0, bf16_t* __restrict__ O1) {
    constexpr int KP = DQ * 2 + 16, VP = 144, VOFF = 64 * KP, BUFB = VOFF + 64 * VP, ND0 = DQ / 16;
    constexpr float THR = 6.0f;
    const int tid = threadIdx.x, lane = tid & 63, wid = tid >> 6, r32 = lane & 31, hi = lane >> 5;
    const int skey = tid >> 3, sch = tid & 7;
    const int pkey = tid >> 2, pch = tid & 3;
    const bf16_t* kg = K1 + (size_t)skey * ldk1 + sch * 8;
    const bf16_t* pg = (DQ == 96) ? (K2 + (size_t)pkey * 32 + pch * 8) : nullptr;
    const bf16_t* vg = Vt + (size_t)skey * S + sch * 8;
    const int kst = skey * KP + sch * 16, pst = pkey * KP + 128 + pch * 16, vst = VOFF + skey * VP + sch * 16;
    const int qlo = 49152 + wid * (2 * 6 * 1024) + lane * 16;
    { const bf16_t* qp0 = Q0 + (size_t)(wid * 32 + r32) * ldq + hi * 8; const bf16_t* qp1 = Q1 + (size_t)(wid * 32 + r32) * ldq + hi * 8;
      {
#pragma unroll
          for (int d0 = 0; d0 < ND0; ++d0) {
              *reinterpret_cast<bf16x8*>(shm + qlo + d0 * 1024) = *reinterpret_cast<const bf16x8*>(qp0 + d0 * 16);
              *reinterpret_cast<bf16x8*>(shm + qlo + (6 + d0) * 1024) = *reinterpret_cast<const bf16x8*>(qp1 + d0 * 16);
          }
      } }
    const int kfo = kperm(r32) * KP + hi * 16;
    const int vfo = VOFF + r32 * VP + hi * 16;
    const int NT = S / 64;
    u32x4 kreg, preg, vreg;
    kreg = *reinterpret_cast<const u32x4*>(kg); vreg = *reinterpret_cast<const u32x4*>(vg);
    if (DQ == 96) { if (tid < 256) preg = *reinterpret_cast<const u32x4*>(pg); }
    __syncthreads();
    *reinterpret_cast<u32x4*>(shm + kst) = kreg; *reinterpret_cast<u32x4*>(shm + vst) = vreg;
    if (DQ == 96) { if (tid < 256) *reinterpret_cast<u32x4*>(shm + pst) = preg; }
    __syncthreads();
    float m_run[2] = {0.f, 0.f}, l_run[2] = {0.f, 0.f};
    f32x16 o[2][2];
#pragma unroll
    for (int sb = 0; sb < 2; ++sb)
#pragma unroll
        for (int r = 0; r < 16; ++r) { o[sb][0][r] = 0.f; o[sb][1][r] = 0.f; }
    for (int t = 0; t < NT; ++t) {
        const unsigned char* buf = shm + (t & 1) * BUFB;
        if (t + 1 < NT) {
            kreg = *reinterpret_cast<const u32x4*>(kg + (size_t)(t + 1) * 64 * ldk1);
            vreg = *reinterpret_cast<const u32x4*>(vg + (t + 1) * 64);
            if (DQ == 96) { if (tid < 256) preg = *reinterpret_cast<const u32x4*>(pg + (size_t)(t + 1) * 64 * 32); }
        }
        const bool first = (t == 0);
        if (DQ == 64) {
            f32x16 p[2][2];
            {
                bf16x8 kf[8], qa[4];
#pragma unroll
                for (int d0 = 0; d0 < 4; ++d0) {
                    kf[2 * d0] = *reinterpret_cast<const bf16x8*>(buf + kfo + d0 * 32);
                    kf[2 * d0 + 1] = *reinterpret_cast<const bf16x8*>(buf + kfo + 32 * KP + d0 * 32);
                    qa[d0] = *reinterpret_cast<const bf16x8*>(shm + qlo + d0 * 1024);
                }
                __builtin_amdgcn_sched_barrier(0);
                f32x16 z; { const float nm = -m_run[0];
#pragma unroll
                  for (int r = 0; r < 16; ++r) z[r] = nm; }
                p[0][0] = __builtin_amdgcn_mfma_f32_32x32x16_bf16(kf[0], qa[0], z, 0, 0, 0);
                p[0][1] = __builtin_amdgcn_mfma_f32_32x32x16_bf16(kf[1], qa[0], z, 0, 0, 0);
#pragma unroll
                for (int d0 = 1; d0 < 4; ++d0) {
                    p[0][0] = __builtin_amdgcn_mfma_f32_32x32x16_bf16(kf[2 * d0], qa[d0], p[0][0], 0, 0, 0);
                    p[0][1] = __builtin_amdgcn_mfma_f32_32x32x16_bf16(kf[2 * d0 + 1], qa[d0], p[0][1], 0, 0, 0);
                }
#pragma unroll
                for (int d0 = 0; d0 < 4; ++d0) qa[d0] = *reinterpret_cast<const bf16x8*>(shm + qlo + (6 + d0) * 1024);
                { const float nm = -m_run[1];
#pragma unroll
                  for (int r = 0; r < 16; ++r) z[r] = nm; }
                p[1][0] = __builtin_amdgcn_mfma_f32_32x32x16_bf16(kf[0], qa[0], z, 0, 0, 0);
                p[1][1] = __builtin_amdgcn_mfma_f32_32x32x16_bf16(kf[1], qa[0], z, 0, 0, 0);
#pragma unroll
                for (int d0 = 1; d0 < 4; ++d0) {
                    p[1][0] = __builtin_amdgcn_mfma_f32_32x32x16_bf16(kf[2 * d0], qa[d0], p[1][0], 0, 0, 0);
                    p[1][1] = __builtin_amdgcn_mfma_f32_32x32x16_bf16(kf[2 * d0 + 1], qa[d0], p[1][1], 0, 0, 0);
                }
                __builtin_amdgcn_sched_barrier(0);
            }
            bf16x8 vf[8];
#pragma unroll
            for (int ks = 0; ks < 4; ++ks) {
                vf[2 * ks] = *reinterpret_cast<const bf16x8*>(buf + vfo + ks * 32);
                vf[2 * ks + 1] = *reinterpret_cast<const bf16x8*>(buf + vfo + 32 * VP + ks * 32);
            }
            __builtin_amdgcn_sched_barrier(0);
            float rm[2];
#pragma unroll
            for (int sb = 0; sb < 2; ++sb) {
                const f32x16& p0 = p[sb][0]; const f32x16& p1 = p[sb][1];
                float a0 = __builtin_fmaxf(__builtin_fmaxf(p0[0], p0[1]), p1[0]), a1 = __builtin_fmaxf(__builtin_fmaxf(p0[2], p0[3]), p1[1]);
                a0 = __builtin_fmaxf(__builtin_fmaxf(a0, p1[2]), p1[3]);
#pragma unroll
                for (int r = 4; r < 16; r += 4) {
                    a0 = __builtin_fmaxf(__builtin_fmaxf(a0, p0[r]), p0[r + 1]); a1 = __builtin_fmaxf(__builtin_fmaxf(a1, p0[r + 2]), p0[r + 3]);
                    a0 = __builtin_fmaxf(__builtin_fmaxf(a0, p1[r]), p1[r + 1]); a1 = __builtin_fmaxf(__builtin_fmaxf(a1, p1[r + 2]), p1[r + 3]);
                }
                rm[sb] = xmax(__builtin_fmaxf(a0, a1));
            }
            if (first || __any((rm[0] > THR) || (rm[1] > THR))) {
#pragma unroll
                for (int sb = 0; sb < 2; ++sb) {
                    const float dl = first ? rm[sb] : fmaxf(rm[sb], 0.f);
                    const float al = first ? 0.f : __builtin_amdgcn_exp2f(-dl);
                    m_run[sb] += dl; l_run[sb] *= al;
#pragma unroll
                    for (int r = 0; r < 16; ++r) { o[sb][0][r] *= al; o[sb][1][r] *= al; p[sb][0][r] -= dl; p[sb][1][r] -= dl; }
                }
            }
#define SM_STEP(SB, PW) do { f32x16& p0 = p[SB][0]; f32x16& p1 = p[SB][1]; float ls0 = 0.f, ls1 = 0.f; \
                _Pragma("unroll") for (int r = 0; r < 16; ++r) { p0[r] = __builtin_amdgcn_exp2f(p0[r]); p1[r] = __builtin_amdgcn_exp2f(p1[r]); } \
                PW[0] = (u32x4){cvtpk(p0[0], p0[1]), cvtpk(p0[2], p0[3]), cvtpk(p0[4], p0[5]), cvtpk(p0[6], p0[7])}; \
                PW[1] = (u32x4){cvtpk(p0[8], p0[9]), cvtpk(p0[10], p0[11]), cvtpk(p0[12], p0[13]), cvtpk(p0[14], p0[15])}; \
                PW[2] = (u32x4){cvtpk(p1[0], p1[1]), cvtpk(p1[2], p1[3]), cvtpk(p1[4], p1[5]), cvtpk(p1[6], p1[7])}; \
                PW[3] = (u32x4){cvtpk(p1[8], p1[9]), cvtpk(p1[10], p1[11]), cvtpk(p1[12], p1[13]), cvtpk(p1[14], p1[15])}; \
                _Pragma("unroll") for (int k = 0; k < 4; ++k) { ls0 = dot2ones(PW[k][0], ls0); ls1 = dot2ones(PW[k][1], ls1); ls0 = dot2ones(PW[k][2], ls0); ls1 = dot2ones(PW[k][3], ls1); } \
                l_run[SB] += ls0 + ls1; } while (0)
            u32x4 pwa[4], pwb[4];
            SM_STEP(0, pwa);
            __builtin_amdgcn_sched_barrier(0);
#pragma unroll
            for (int ks = 0; ks < 4; ++ks) {
                const bf16x8 pb = __builtin_bit_cast(bf16x8, pwa[ks]);
                o[0][0] = __builtin_amdgcn_mfma_f32_32x32x16_bf16(vf[2 * ks], pb, o[0][0], 0, 0, 0);
                o[0][1] = __builtin_amdgcn_mfma_f32_32x32x16_bf16(vf[2 * ks + 1], pb, o[0][1], 0, 0, 0);
            }
            SM_STEP(1, pwb);
#pragma unroll
            for (int g = 0; g < 8; ++g) { __builtin_amdgcn_sched_group_barrier(0x008, 1, 0); __builtin_amdgcn_sched_group_barrier(0x002 | 0x400, 14, 0); }
            __builtin_amdgcn_sched_barrier(0);
#undef SM_STEP
#pragma unroll
            for (int ks = 0; ks < 4; ++ks) {
                const bf16x8 pb = __builtin_bit_cast(bf16x8, pwb[ks]);
                o[1][0] = __builtin_amdgcn_mfma_f32_32x32x16_bf16(vf[2 * ks], pb, o[1][0], 0, 0, 0);
                o[1][1] = __builtin_amdgcn_mfma_f32_32x32x16_bf16(vf[2 * ks + 1], pb, o[1][1], 0, 0, 0);
            }
            __builtin_amdgcn_sched_barrier(0);
        } else {
#define QK_STEP(SB, P0, P1) do { \
            _Pragma("unroll") for (int kh = 0; kh < 2; ++kh) { \
                bf16x8 kf[6]; \
                _Pragma("unroll") for (int dd = 0; dd < 3; ++dd) { \
                    kf[2 * dd] = *reinterpret_cast<const bf16x8*>(buf + kfo + (kh * 3 + dd) * 32); \
                    kf[2 * dd + 1] = *reinterpret_cast<const bf16x8*>(buf + kfo + 32 * KP + (kh * 3 + dd) * 32); } \
                __builtin_amdgcn_sched_barrier(0); \
                _Pragma("unroll") for (int dd = 0; dd < 3; ++dd) { \
                    const bf16x8 qf = *reinterpret_cast<const bf16x8*>(shm + qlo + ((SB) * 6 + kh * 3 + dd) * 1024); \
                    if (kh == 0 && dd == 0) { f32x16 z; { const float nm = -m_run[SB]; _Pragma("unroll") for (int r = 0; r < 16; ++r) z[r] = nm; } \
                        P0 = __builtin_amdgcn_mfma_f32_32x32x16_bf16(kf[0], qf, z, 0, 0, 0); P1 = __builtin_amdgcn_mfma_f32_32x32x16_bf16(kf[1], qf, z, 0, 0, 0); } \
                    else { P0 = __builtin_amdgcn_mfma_f32_32x32x16_bf16(kf[2 * dd], qf, P0, 0, 0, 0); P1 = __builtin_amdgcn_mfma_f32_32x32x16_bf16(kf[2 * dd + 1], qf, P1, 0, 0, 0); } } \
                __builtin_amdgcn_sched_barrier(0); } } while (0)
#define ROWMAX_RESCALE(SB, P0, P1) do { \
            float a0 = __builtin_fmaxf(__builtin_fmaxf(P0[0], P0[1]), P1[0]), a1 = __builtin_fmaxf(__builtin_fmaxf(P0[2], P0[3]), P1[1]); \
            a0 = __builtin_fmaxf(__builtin_fmaxf(a0, P1[2]), P1[3]); \
            _Pragma("unroll") for (int r = 4; r < 16; r += 4) { \
                a0 = __builtin_fmaxf(__builtin_fmaxf(a0, P0[r]), P0[r + 1]); a1 = __builtin_fmaxf(__builtin_fmaxf(a1, P0[r + 2]), P0[r + 3]); \
                a0 = __builtin_fmaxf(__builtin_fmaxf(a0, P1[r]), P1[r + 1]); a1 = __builtin_fmaxf(__builtin_fmaxf(a1, P1[r + 2]), P1[r + 3]); } \
            const float rm = xmax(__builtin_fmaxf(a0, a1));   \
            if (first || __any(rm > THR)) { \
                const float dl = first ? rm : fmaxf(rm, 0.f); const float al = first ? 0.f : __builtin_amdgcn_exp2f(-dl); \
                m_run[SB] += dl; l_run[SB] *= al; \
                _Pragma("unroll") for (int r = 0; r < 16; ++r) { o[SB][0][r] *= al; o[SB][1][r] *= al; P0[r] -= dl; P1[r] -= dl; } } } while (0)
#define SM_STEP(SB, P0, P1, PW) do { float ls0 = 0.f, ls1 = 0.f; \
            _Pragma("unroll") for (int r = 0; r < 16; ++r) { P0[r] = __builtin_amdgcn_exp2f(P0[r]); P1[r] = __builtin_amdgcn_exp2f(P1[r]); } \
            PW[0] = (u32x4){cvtpk(P0[0], P0[1]), cvtpk(P0[2], P0[3]), cvtpk(P0[4], P0[5]), cvtpk(P0[6], P0[7])}; \
            PW[1] = (u32x4){cvtpk(P0[8], P0[9]), cvtpk(P0[10], P0[11]), cvtpk(P0[12], P0[13]), cvtpk(P0[14], P0[15])}; \
            PW[2] = (u32x4){cvtpk(P1[0], P1[1]), cvtpk(P1[2], P1[3]), cvtpk(P1[4], P1[5]), cvtpk(P1[6], P1[7])}; \
            PW[3] = (u32x4){cvtpk(P1[8], P1[9]), cvtpk(P1[10], P1[11]), cvtpk(P1[12], P1[13]), cvtpk(P1[14], P1[15])}; \
            _Pragma("unroll") for (int k = 0; k < 4; ++k) { ls0 = dot2ones(PW[k][0], ls0); ls1 = dot2ones(PW[k][1], ls1); ls0 = dot2ones(PW[k][2], ls0); ls1 = dot2ones(PW[k][3], ls1); } \
            l_run[SB] += ls0 + ls1; } while (0)
            u32x4 pwa[4], pwb[4];
            {
                f32x16 pa0, pa1;
                QK_STEP(0, pa0, pa1);
                ROWMAX_RESCALE(0, pa0, pa1);
                SM_STEP(0, pa0, pa1, pwa);
                __builtin_amdgcn_sched_barrier(0);
            }
            f32x16 pb0, pb1;
            QK_STEP(1, pb0, pb1);
            bf16x8 vf[8];
#pragma unroll
            for (int ks = 0; ks < 4; ++ks) {
                vf[2 * ks] = *reinterpret_cast<const bf16x8*>(buf + vfo + ks * 32);
                vf[2 * ks + 1] = *reinterpret_cast<const bf16x8*>(buf + vfo + 32 * VP + ks * 32);
            }
            ROWMAX_RESCALE(1, pb0, pb1);
            __builtin_amdgcn_sched_barrier(0);
#pragma unroll
            for (int ks = 0; ks < 4; ++ks) {
                const bf16x8 pb = __builtin_bit_cast(bf16x8, pwa[ks]);
                o[0][0] = __builtin_amdgcn_mfma_f32_32x32x16_bf16(vf[2 * ks], pb, o[0][0], 0, 0, 0);
                o[0][1] = __builtin_amdgcn_mfma_f32_32x32x16_bf16(vf[2 * ks + 1], pb, o[0][1], 0, 0, 0);
            }
            SM_STEP(1, pb0, pb1, pwb);
#pragma unroll
            for (int g = 0; g < 8; ++g) { __builtin_amdgcn_sched_group_barrier(0x008, 1, 0); __builtin_amdgcn_sched_group_barrier(0x002 | 0x400, 14, 0); }
            __builtin_amdgcn_sched_barrier(0);
#undef QK_STEP
#undef ROWMAX_RESCALE
#undef SM_STEP
#pragma unroll
            for (int ks = 0; ks < 4; ++ks) {
                const bf16x8 pb = __builtin_bit_cast(bf16x8, pwb[ks]);
                o[1][0] = __builtin_amdgcn_mfma_f32_32x32x16_bf16(vf[2 * ks], pb, o[1][0], 0, 0, 0);
                o[1][1] = __builtin_amdgcn_mfma_f32_32x32x16_bf16(vf[2 * ks + 1], pb, o[1][1], 0, 0, 0);
            }
            __builtin_amdgcn_sched_barrier(0);
        }
        if (t + 1 < NT) {
            unsigned char* nb = shm + ((t + 1) & 1) * BUFB;
            *reinterpret_cast<u32x4*>(nb + kst) = kreg; *reinterpret_cast<u32x4*>(nb + vst) = vreg;
            if (DQ == 96) { if (tid < 256) *reinterpret_cast<u32x4*>(nb + pst) = preg; }
        }
        __syncthreads();
    }
#pragma unroll
    for (int sb = 0; sb < 2; ++sb) {
        const float lt = xsum(l_run[sb]);
        const float inv = 1.0f / lt;
        bf16_t* op = (sb == 0 ? O0 : O1) + (size_t)(wid * 32 + r32) * DM + 4 * hi;
#pragma unroll
        for (int g = 0; g < 4; ++g) {
            *reinterpret_cast<u32x2*>(op + 8 * g) = (u32x2){cvtpk(o[sb][0][4 * g] * inv, o[sb][0][4 * g + 1] * inv), cvtpk(o[sb][0][4 * g + 2] * inv, o[sb][0][4 * g + 3] * inv)};
            *reinterpret_cast<u32x2*>(op + 32 + 8 * g) = (u32x2){cvtpk(o[sb][1][4 * g] * inv, o[sb][1][4 * g + 1] * inv), cvtpk(o[sb][1][4 * g + 2] * inv, o[sb][1][4 * g + 3] * inv)};
        }
    }
}

template <int MODE>
__device__ __forceinline__ void conv_weight(const float* __restrict__ W, int K, int N, bf16_t* __restrict__ dst, int ldb,
                                            const float* __restrict__ gA, const float* __restrict__ gB, int gtid, int gthreads) {
    const int total = N * (K / 8);
    for (int i = gtid; i < total; i += gthreads) {
        const int kq = i / N, n = i - kq * N, k0 = kq * 8;
        float v[8];
#pragma unroll
        for (int j = 0; j < 8; ++j) {
            float w = W[(size_t)(k0 + j) * N + n];
            if (MODE == 1) w *= gA[k0 + j];
            if (MODE == 2) w *= (k0 + j < 512) ? gA[k0 + j] : gB[k0 + j - 512];
            v[j] = w;
        }
        int row = n;
        if (MODE == 3) row = (n >> 7) * 256 + (n & 127);
        if (MODE == 4) row = (n >> 7) * 256 + 128 + (n & 127);
        *reinterpret_cast<u32x4*>(dst + (size_t)row * ldb + k0) = (u32x4){cvtpk(v[0], v[1]), cvtpk(v[2], v[3]), cvtpk(v[4], v[5]), cvtpk(v[6], v[7])};
    }
}

#define LAS __attribute__((address_space(3)))
#define XB_TMO      128
#define XB_XCNT(j)  (256  + 64 * (j))
#define XB_XSUB(j)  (1280 + 64 * (j))
#define XB_XGEN(j)  (2304 + 64 * (j))
#define XB_TOP      3328
#define XB_TOPGEN   3392
#define XCD_BAR_WORDS 3456
#define XB_SPIN_CAP (1u << 18)
__device__ __forceinline__ unsigned xb_ld(unsigned* p)              { return __hip_atomic_load(p, __ATOMIC_RELAXED, __HIP_MEMORY_SCOPE_AGENT); }
__device__ __forceinline__ unsigned xb_add(unsigned* p, unsigned v) { return __hip_atomic_fetch_add(p, v, __ATOMIC_RELAXED, __HIP_MEMORY_SCOPE_AGENT); }
__device__ __forceinline__ unsigned xb_xcc_id() { return (unsigned)__builtin_amdgcn_s_getreg((3 << 11) | 20) & 0xFu; }
#define XB_SPIN(cond, bar) do { unsigned _sp = 0; while (cond) { __builtin_amdgcn_s_sleep(1); \
    if ((++_sp & 255u) == 0u) { if (xb_ld(&(bar)[XB_TMO])) break; if (_sp > XB_SPIN_CAP) { atomicAdd(&(bar)[XB_TMO], 1u); break; } } } } while (0)
__device__ __forceinline__ void xcd_barrier_complete(unsigned* bar, unsigned x, unsigned& nloc, unsigned& nx) {
    const unsigned G = gridDim.x * gridDim.y * gridDim.z;
    unsigned sum, cnt, mine, sp = 0u;
    for (;;) {
        sum = 0u; cnt = 0u; mine = 0u;
#pragma unroll
        for (unsigned j = 0; j < 16; ++j) { const unsigned c = xb_ld(&bar[XB_XCNT(j)]); sum += c; cnt += (c > 0u) ? 1u : 0u; mine = (j == x) ? c : mine; }
        if (sum == G) break;
        __builtin_amdgcn_s_sleep(1);
        if ((++sp & 255u) == 0u) { if (xb_ld(&bar[XB_TMO])) break; if (sp > XB_SPIN_CAP) { atomicAdd(&bar[XB_TMO], 1u); break; } }
    }
    nloc = mine > 0u ? mine : 1u; nx = cnt > 0u ? cnt : 1u;
}
__device__ __forceinline__ void xcd_barrier(unsigned* bar, unsigned x, volatile LAS unsigned* st, bool leader) {
    asm volatile("s_waitcnt vmcnt(0)" ::: "memory");
    __syncthreads();
    if (leader) {
        __builtin_amdgcn_s_waitcnt(0);
        unsigned nloc = st[0], nx = st[1];
        if (nloc == 0u) { xcd_barrier_complete(bar, x, nloc, nx); st[0] = nloc; st[1] = nx; }
        const unsigned old = xb_add(&bar[XB_XSUB(x)], 1u);
        const unsigned gen = old / nloc;
        if (old + 1u == (gen + 1u) * nloc) {
            __builtin_amdgcn_fence(__ATOMIC_RELEASE, "agent");
            asm volatile("s_waitcnt vmcnt(0)" ::: "memory");
            const unsigned og = xb_add(&bar[XB_TOP], 1u);
            const unsigned tg = og / nx;
            if (og + 1u == (tg + 1u) * nx) xb_add(&bar[XB_TOPGEN], 1u);
            else XB_SPIN(xb_ld(&bar[XB_TOPGEN]) == tg, bar);
            __builtin_amdgcn_fence(__ATOMIC_ACQUIRE, "agent");
            xb_add(&bar[XB_XGEN(x)], 1u);
            asm volatile("s_waitcnt vmcnt(0)" ::: "memory");
        } else {
            XB_SPIN(xb_ld(&bar[XB_XGEN(x)]) == gen, bar);
            __builtin_amdgcn_fence(__ATOMIC_ACQUIRE, "agent");
            asm volatile("s_waitcnt vmcnt(0)" ::: "memory");
        }
    }
    __syncthreads();
}

__global__ void __launch_bounds__(512) fwd_kernel(Params p) {
    extern __shared__ __attribute__((aligned(16))) unsigned char lds[];
    cg::grid_group grid = cg::this_grid();
    const int tid = threadIdx.x, lane = tid & 63, wv = tid >> 6;
    const int G = gridDim.x, bx = blockIdx.x;
    const int vcu = ((G & 7) == 0) ? (bx % 8) * (G / 8) + bx / 8 : bx;
    unsigned char* ws = p.ws;
    const float* xp = p.in[0]; const float* xs = p.in[1];
    bf16_t* W1t = (bf16_t*)(ws + WS_W1T); bf16_t* Wuqt = (bf16_t*)(ws + WS_WUQT); bf16_t* Wukvt = (bf16_t*)(ws + WS_WUKVT);
    bf16_t* Woutt = (bf16_t*)(ws + WS_WOUTT); bf16_t* Wgut = (bf16_t*)(ws + WS_WGUT); bf16_t* Wdnt = (bf16_t*)(ws + WS_WDNT);
    float* mod = (float*)(ws + WS_MOD);
    float* cosA = (float*)(ws + WS_COSA); float* sinA = (float*)(ws + WS_SINA); float* cosB = (float*)(ws + WS_COSB); float* sinB = (float*)(ws + WS_SINB);
    float* rsq = (float*)(ws + WS_RSQ); float* rskv = (float*)(ws + WS_RSKV);
    bf16_t* U = (bf16_t*)(ws + WS_U); bf16_t* H = (bf16_t*)(ws + WS_H); bf16_t* Ob = (bf16_t*)(ws + WS_O);
    bf16_t* Qa = (bf16_t*)(ws + WS_QA); bf16_t* Ka = (bf16_t*)(ws + WS_KA); bf16_t* Vta = (bf16_t*)(ws + WS_VTA);
    bf16_t* Qm = (bf16_t*)(ws + WS_QM); bf16_t* Kn = (bf16_t*)(ws + WS_KN); bf16_t* Kpe = (bf16_t*)(ws + WS_KPE); bf16_t* Vtm = (bf16_t*)(ws + WS_VTM);
    bf16_t* F = (bf16_t*)(ws + WS_F);
    float* out = p.out;
    const int lo = p.lo, hi_ = p.hi;
#ifndef PH_MASK
#define PH_MASK 0xFFF
#endif
#define IN(k) (((PH_MASK >> (k)) & 1) && lo <= (k) && (k) < hi_)
#define SEAM(k) do { if (IN(k) && IN((k) + 1)) { if ((k) == 0) grid.sync(); else xcd_barrier(xbar, xcc, xst, tid == 0); } } while (0)
    unsigned* const xbar = (unsigned*)(p.ws + WS_BAR);
    volatile LAS unsigned* const xst = (volatile LAS unsigned*)((LAS unsigned char*)lds + LDS_XST);
    const unsigned xcc = xb_xcc_id();
    if (tid == 0) { xst[0] = 0u; xst[1] = 0u; (void)xb_add(&xbar[XB_XCNT(xcc)], 1u); }
    __syncthreads();

    if (IN(0)) {
        float* s_c = (float*)lds;
        float* red = (float*)(lds + 65536);
        const float* cpr = p.in[2]; const float* csm = p.in[3]; const float* w_ada = p.in[4]; const float* b_ada = p.in[5];
        for (int cb = bx; cb < 192; cb += G) {
            for (int i = tid; i < 16 * 1024; i += 512) {
                const int b = i >> 10, k = i & 1023; const float c = (b < 8) ? cpr[b * 1024 + k] : csm[(b - 8) * 1024 + k];
                s_c[i] = c / (1.0f + __expf(-c));
            }
            __syncthreads();
            const int kgp = tid >> 5, cl = tid & 31, col = cb * 32 + cl;
            float a[16];
#pragma unroll
            for (int b = 0; b < 16; ++b) a[b] = 0.f;
            for (int k = kgp * 64; k < kgp * 64 + 64; ++k) {
                const float w = w_ada[(size_t)k * 6144 + col];
#pragma unroll
                for (int b = 0; b < 16; ++b) a[b] += s_c[b * 1024 + k] * w;
            }
#pragma unroll
            for (int b = 0; b < 16; ++b) red[(kgp * 16 + b) * 32 + cl] = a[b];
            __syncthreads();
            { const int b = tid >> 5; float s = 0.f;
#pragma unroll
              for (int k2 = 0; k2 < 16; ++k2) s += red[(k2 * 16 + b) * 32 + cl];
              mod[b * 6144 + col] = s + b_ada[col]; }
            __syncthreads();
        }
        const int gtid = bx * 512 + tid, gth = G * 512;
        for (int i = gtid; i < 8192 * 48; i += gth) {
            const int s = i / 48, j = i - s * 48;
            int ii, n; if (j < 32) { ii = j; n = 16; } else { ii = j - 32; n = 8; }
            const int pos = (ii < n) ? (s >> 6) : (s & 63); const int fi = (ii < n) ? ii : ii - n;
            const float inv = exp2f(-((float)fi / (float)n) * 13.287712379549449f);
            const float ang = (float)pos * inv;
            const double rev = (double)ang * 0.15915494309189535; const float fr_ = (float)(rev - floor(rev));
            const float cv = __builtin_amdgcn_cosf(fr_), sv = __builtin_amdgcn_sinf(fr_);
            if (j < 32) { cosA[s * 32 + ii] = cv; sinA[s * 32 + ii] = sv; } else { cosB[s * 16 + ii] = cv; sinB[s * 16 + ii] = sv; }
        }
        conv_weight<0>(p.in[6], 1024, 1184, W1t, 1024, nullptr, nullptr, gtid, gth);
        for (int i = gtid; i < 96 * 1024 / 8; i += gth) *reinterpret_cast<u32x4*>(W1t + (size_t)1184 * 1024 + (size_t)i * 8) = (u32x4){0u, 0u, 0u, 0u};
        conv_weight<1>(p.in[10], 256, 768, Wuqt, 256, p.in[9], nullptr, gtid, gth);
        conv_weight<1>(p.in[12], 128, 1024, Wukvt, 256, p.in[11], nullptr, gtid, gth);
        for (int i = gtid; i < 1024 * 16; i += gth) { const int r = i >> 4, c = i & 15; *reinterpret_cast<u32x4*>(Wukvt + (size_t)r * 256 + 128 + c * 8) = (u32x4){0u, 0u, 0u, 0u}; }
        conv_weight<2>(p.in[15], 1024, 1024, Woutt, 1024, p.in[13], p.in[14], gtid, gth);
        conv_weight<3>(p.in[18], 1024, 2816, Wgut, 1024, nullptr, nullptr, gtid, gth);
        conv_weight<4>(p.in[19], 1024, 2816, Wgut, 1024, nullptr, nullptr, gtid, gth);
        conv_weight<0>(p.in[20], 2816, 1024, Wdnt, 2816, nullptr, nullptr, gtid, gth);
    }
    SEAM(0);

    if (IN(1)) {
        constexpr int NR = 4;
        for (int t0 = bx * 8 + wv; t0 < T; t0 += NR * G * 8) {
            f32x4 v[NR][4];
#pragma unroll
            for (int rr = 0; rr < NR; ++rr) {
                const int t = t0 + rr * G * 8; const float* xr = xrow(xp, xs, t < T ? t : t0);
#pragma unroll
                for (int c = 0; c < 4; ++c) v[rr][c] = *reinterpret_cast<const f32x4*>(xr + c * 256 + lane * 4);
            }
#pragma unroll
            for (int rr = 0; rr < NR; ++rr) {
                const int t = t0 + rr * G * 8;
                float s = 0.f;
#pragma unroll
                for (int c = 0; c < 4; ++c) s += (v[rr][c][0] + v[rr][c][1]) + (v[rr][c][2] + v[rr][c][3]);
                const float mean = wave_sum(s) * (1.0f / 1024.0f);
                float q = 0.f;
#pragma unroll
                for (int c = 0; c < 4; ++c) { v[rr][c] = v[rr][c] - mean; q += (v[rr][c][0] * v[rr][c][0] + v[rr][c][1] * v[rr][c][1]) + (v[rr][c][2] * v[rr][c][2] + v[rr][c][3] * v[rr][c][3]); }
                const float rstd = rsqrtf(wave_sum(q) * (1.0f / 1024.0f) + EPS);
                if (t < T) {
                    int b, S, tok0; tokinfo(t, b, S, tok0);
                    const float* md = mod + b * 6144;
#pragma unroll
                    for (int c = 0; c < 4; ++c) {
                        const int col = c * 256 + lane * 4;
                        const f32x4 sh = *reinterpret_cast<const f32x4*>(md + col), sc = *reinterpret_cast<const f32x4*>(md + 1024 + col);
                        const f32x4 y = v[rr][c] * rstd * (sc + 1.0f) + sh;
                        *reinterpret_cast<u32x2*>(U + (size_t)t * DM + col) = (u32x2){cvtpk(y[0], y[1]), cvtpk(y[2], y[3])};
                    }
                }
            }
        }
    }
    SEAM(1);

    if (IN(2)) {
        int pm, pn;
        for (int i = 0; tile_next(i, G, bx, NMT, 5, pm, pn); ++i) {
            f32x4 acc[2][2][4][2];
            const int brow = pm * 256, bcol = pn * 256;
            int b, S, tok0; tokinfo(brow, b, S, tok0);
            if (pn == 2) {
                gemm_core<false>(lds, U, DM, W1t, DM, 16, brow, bcol, acc);
                EPI_GEOM
#pragma unroll
                for (int ai = 0; ai < 2; ++ai)
#pragma unroll
                    for (int m = 0; m < 4; ++m) {
                        asm volatile("" ::: "memory"); const int row = brow + ai * 128 + wr * 64 + m * 16 + fq * 4;
#pragma unroll
                        for (int bj = 0; bj < 2; ++bj)
#pragma unroll
                            for (int n = 0; n < 2; ++n) {
                                const int col = bcol + bj * 128 + wc * 32 + n * 16 + fr; const f32x4 v = acc[ai][bj][m][n];
                                if (bj == 1) {
                                    const size_t off = (size_t)tok0 * 128 + (size_t)(col - 640) * S + (row - tok0);
                                    *reinterpret_cast<u32x2*>(Vta + off) = (u32x2){cvtpk(v[0], v[1]), cvtpk(v[2], v[3])};
                                } else {
#pragma unroll
                                    for (int j = 0; j < 4; ++j) H[(size_t)(row + j) * HP + col] = f2bf(v[j]);
                                }
                            }
                    }
            } else {
                gemm_core<true>(lds, U, DM, W1t, DM, 16, brow, bcol, acc);
                EPI_GEOM
#pragma unroll
                for (int ai = 0; ai < 2; ++ai)
#pragma unroll
                    for (int m = 0; m < 4; ++m) {
                        asm volatile("" ::: "memory"); const int row = brow + ai * 128 + wr * 64 + m * 16 + fr;
#pragma unroll
                        for (int bj = 0; bj < 2; ++bj)
#pragma unroll
                            for (int n = 0; n < 2; ++n) {
                                const int c0 = bcol + bj * 128 + wc * 32 + n * 16 + fq * 4; const f32x4 v = acc[ai][bj][m][n];
                                *reinterpret_cast<u32x2*>(H + (size_t)row * HP + c0) = (u32x2){cvtpk(v[0], v[1]), cvtpk(v[2], v[3])};
                            }
                    }
                if (pn >= 3) {
                    float* part = (float*)(ws + (pn == 3 ? WS_PQ : WS_PKV));
#pragma unroll
                    for (int ai = 0; ai < 2; ++ai)
#pragma unroll
                        for (int m = 0; m < 4; ++m) {
                            const int row = brow + ai * 128 + wr * 64 + m * 16 + fr;
                            float sq = 0.f;
#pragma unroll
                            for (int n = 0; n < 2; ++n) {
                                const f32x4 v0 = acc[ai][0][m][n], v1 = acc[ai][1][m][n];
                                sq += (v0[0] * v0[0] + v0[1] * v0[1]) + (v0[2] * v0[2] + v0[3] * v0[3]);
                                if (pn == 3) sq += (v1[0] * v1[0] + v1[1] * v1[1]) + (v1[2] * v1[2] + v1[3] * v1[3]);
                            }
                            sq += __shfl_xor(sq, 16); sq += __shfl_xor(sq, 32);
                            part[(size_t)row * 4 + wc] = sq;
                        }
                }
            }
        }
    }
    SEAM(2);

    if (IN(3)) {
        const float* gq = p.in[7]; const float* gk = p.in[8];
        for (int t = bx * 8 + wv; t < T; t += G * 8) {
            int b, S, tok0; tokinfo(t, b, S, tok0); const int s = t - tok0;
            const bf16_t* hr = H + (size_t)t * HP;
            if (lane < 40) {
                const int hh = lane >> 2, c = lane & 3; const bool isq = hh < 8;
                const u32x4 a1 = *reinterpret_cast<const u32x4*>(hr + hh * 64 + c * 8), a2 = *reinterpret_cast<const u32x4*>(hr + hh * 64 + 32 + c * 8);
                float x1[8], x2[8]; float ss = 0.f;
#pragma unroll
                for (int e = 0; e < 4; ++e) {
                    x1[2 * e] = __uint_as_float(a1[e] << 16); x1[2 * e + 1] = __uint_as_float(a1[e] & 0xffff0000u);
                    x2[2 * e] = __uint_as_float(a2[e] << 16); x2[2 * e + 1] = __uint_as_float(a2[e] & 0xffff0000u);
                }
#pragma unroll
                for (int e = 0; e < 8; ++e) ss += x1[e] * x1[e] + x2[e] * x2[e];
                ss += __shfl_xor(ss, 1); ss += __shfl_xor(ss, 2);
                const float rstd = rsqrtf(ss * (1.0f / 64.0f) + EPS);
                const float* g = isq ? gq : gk; const float scl = isq ? C2A : 1.0f;
                float o1[8], o2[8];
#pragma unroll
                for (int e = 0; e < 8; ++e) {
                    const int d1 = c * 8 + e;
                    const float a = x1[e] * rstd * g[d1], bb = x2[e] * rstd * g[d1 + 32];
                    const float cs = cosA[s * 32 + d1], sn = sinA[s * 32 + d1];
                    o1[e] = (a * cs - bb * sn) * scl; o2[e] = (a * sn + bb * cs) * scl;
                }
                bf16_t* dst = isq ? (Qa + (size_t)t * 512 + hh * 64 + c * 8) : (Ka + (size_t)t * 128 + (hh - 8) * 64 + c * 8);
                *reinterpret_cast<u32x4*>(dst) = (u32x4){cvtpk(o1[0], o1[1]), cvtpk(o1[2], o1[3]), cvtpk(o1[4], o1[5]), cvtpk(o1[6], o1[7])};
                *reinterpret_cast<u32x4*>(dst + 32) = (u32x4){cvtpk(o2[0], o2[1]), cvtpk(o2[2], o2[3]), cvtpk(o2[4], o2[5]), cvtpk(o2[6], o2[7])};
            }
            if (lane < 2) {
                const u32x4 a1 = *reinterpret_cast<const u32x4*>(hr + 1152 + lane * 8), a2 = *reinterpret_cast<const u32x4*>(hr + 1152 + 16 + lane * 8);
                float o1[8], o2[8];
#pragma unroll
                for (int e = 0; e < 4; ++e) {
#pragma unroll
                    for (int h2 = 0; h2 < 2; ++h2) {
                        const int ee = 2 * e + h2, i = lane * 8 + ee;
                        const float a = h2 ? __uint_as_float(a1[e] & 0xffff0000u) : __uint_as_float(a1[e] << 16);
                        const float bb = h2 ? __uint_as_float(a2[e] & 0xffff0000u) : __uint_as_float(a2[e] << 16);
                        const float cs = cosB[s * 16 + i], sn = sinB[s * 16 + i];
                        o1[ee] = a * cs - bb * sn; o2[ee] = a * sn + bb * cs;
                    }
                }
                bf16_t* dst = Kpe + (size_t)t * 32 + lane * 8;
                *reinterpret_cast<u32x4*>(dst) = (u32x4){cvtpk(o1[0], o1[1]), cvtpk(o1[2], o1[3]), cvtpk(o1[4], o1[5]), cvtpk(o1[6], o1[7])};
                *reinterpret_cast<u32x4*>(dst + 16) = (u32x4){cvtpk(o2[0], o2[1]), cvtpk(o2[2], o2[3]), cvtpk(o2[4], o2[5]), cvtpk(o2[6], o2[7])};
            }
        }
    }

    if (IN(4)) {
        int pm, pn;
        for (int i = 0; tile_next(i, G, bx, NMT, 7, pm, pn); ++i) {
            f32x4 acc[2][2][4][2];
            const int brow = pm * 256;
            const bool isq = pn < 3;
            const bf16_t* A = H + (isq ? 768 : 1024);
            const bf16_t* Bt = isq ? Wuqt : Wukvt;
            const int bcol = isq ? pn * 256 : (pn - 3) * 256;
            int b, S, tok0; tokinfo(brow, b, S, tok0);
            if (isq) {
                gemm_core<true>(lds, A, HP, Bt, 256, 4, brow, bcol, acc);
                EPI_GEOM
#pragma unroll
                for (int ai = 0; ai < 2; ++ai)
#pragma unroll
                    for (int m = 0; m < 4; ++m) {
                        asm volatile("" ::: "memory"); const int row = brow + ai * 128 + wr * 64 + m * 16 + fr;
                        const f32x4 pq = *reinterpret_cast<const f32x4*>((const float*)(ws + WS_PQ) + (size_t)row * 4);
                        const float rs = rsqrtf(((pq[0] + pq[1]) + (pq[2] + pq[3])) * (1.0f / 256.0f) + EPS) * C2M; const int sp = row - tok0;
                        const f32x4 cs = *reinterpret_cast<const f32x4*>(cosB + sp * 16 + fq * 4), sn = *reinterpret_cast<const f32x4*>(sinB + sp * 16 + fq * 4);
#pragma unroll
                        for (int bj = 0; bj < 2; ++bj) {
                            const int g32 = pn * 8 + bj * 4 + wc; const bool isrope = (g32 % 3) == 2; const int colb = g32 * 32 + fq * 4;
                            f32x4 v0 = acc[ai][bj][m][0] * rs, v1 = acc[ai][bj][m][1] * rs;
                            if (isrope) { const f32x4 ra = v0 * cs - v1 * sn, rb = v0 * sn + v1 * cs; v0 = ra; v1 = rb; }
                            *reinterpret_cast<u32x2*>(Qm + (size_t)row * 768 + colb) = (u32x2){cvtpk(v0[0], v0[1]), cvtpk(v0[2], v0[3])};
                            *reinterpret_cast<u32x2*>(Qm + (size_t)row * 768 + colb + 16) = (u32x2){cvtpk(v1[0], v1[1]), cvtpk(v1[2], v1[3])};
                        }
                    }
            } else {
                gemm_core<false>(lds, A, HP, Bt, 256, 4, brow, bcol, acc);
                EPI_GEOM
#pragma unroll
                for (int ai = 0; ai < 2; ++ai)
#pragma unroll
                    for (int m = 0; m < 4; ++m) {
                        asm volatile("" ::: "memory"); const int row = brow + ai * 128 + wr * 64 + m * 16 + fq * 4;
                        float rs[4];
#pragma unroll
                        for (int j = 0; j < 4; ++j) { const f32x4 pk = *reinterpret_cast<const f32x4*>((const float*)(ws + WS_PKV) + (size_t)(row + j) * 4); rs[j] = rsqrtf(((pk[0] + pk[1]) + (pk[2] + pk[3])) * (1.0f / 128.0f) + EPS); }
#pragma unroll
                        for (int bj = 0; bj < 2; ++bj) {
                            const int head = (pn - 3) * 2 + bj;
#pragma unroll
                            for (int n = 0; n < 2; ++n) {
                                const int within = wc * 32 + n * 16 + fr; const f32x4 v = acc[ai][bj][m][n];
                                if (wc < 2) {
#pragma unroll
                                    for (int j = 0; j < 4; ++j) Kn[(size_t)(row + j) * 512 + head * 64 + within] = f2bf(v[j] * rs[j]);
                                } else {
                                    const size_t off = (size_t)tok0 * 512 + (size_t)(head * 64 + within - 64) * S + (row - tok0);
                                    *reinterpret_cast<u32x2*>(Vtm + off) = (u32x2){cvtpk(v[0] * rs[0], v[1] * rs[1]), cvtpk(v[2] * rs[2], v[3] * rs[3])};
                                }
                            }
                        }
                    }
            }
        }
    }
    SEAM(4);

    if (IN(5)) {
#ifndef NO_MLA
        for (int u = vcu; u < 1280; u += G) {
            const bool smp = u < 1024; const int idx = smp ? u : u - 1024;
            const int S = smp ? 8192 : 2048;
            const int nqb = S / 512, qb = idx % nqb, head = (idx / nqb) & 7, bl = idx / (nqb * 8);
            const int tok0 = smp ? TP + bl * 8192 : bl * 2048, q0 = tok0 + qb * 512;
            const bf16_t* q = Qm + (size_t)q0 * 768 + head * 96; bf16_t* o = Ob + (size_t)q0 * DM + 512 + head * 64;
            attn_unit2<96>(lds, q, q + (size_t)256 * 768, 768, Kn + (size_t)tok0 * 512 + head * 64, 512, Kpe + (size_t)tok0 * 32,
                           Vtm + (size_t)tok0 * 512 + (size_t)head * 64 * S, S, o, o + (size_t)256 * DM);
        }
#endif
#ifndef NO_GQA
        for (int u = vcu; u < 1280; u += G) {
            const bool smp = u < 1024; const int idx = smp ? u : u - 1024;
            const int S = smp ? 8192 : 2048;
            const int nqb = S / 256, qb = idx % nqb, hp = (idx / nqb) & 3, bl = idx / (nqb * 4);
            const int kvh = hp >> 1, head = hp * 2;
            const int tok0 = smp ? TP + bl * 8192 : bl * 2048, q0 = tok0 + qb * 256;
            const bf16_t* q = Qa + (size_t)q0 * 512 + head * 64; bf16_t* o = Ob + (size_t)q0 * DM + head * 64;
            attn_unit2<64>(lds, q, q + 64, 512, Ka + (size_t)tok0 * 128 + kvh * 64, 128, nullptr,
                           Vta + (size_t)tok0 * 128 + (size_t)kvh * 64 * S, S, o, o + 64);
        }
#endif
    }
    SEAM(5);

    if (IN(6)) {
        constexpr int NR = 4;
        for (int t0 = bx * 8 + wv; t0 < T; t0 += NR * G * 8) {
            u32x4 ra[NR], rc[NR];
#pragma unroll
            for (int rr = 0; rr < NR; ++rr) {
                const int t = t0 + rr * G * 8; const bf16_t* orow = Ob + (size_t)(t < T ? t : t0) * DM + lane * 16;
                ra[rr] = *reinterpret_cast<const u32x4*>(orow); rc[rr] = *reinterpret_cast<const u32x4*>(orow + 8);
            }
#pragma unroll
            for (int rr = 0; rr < NR; ++rr) {
                const int t = t0 + rr * G * 8;
                float x[16];
#pragma unroll
                for (int e = 0; e < 4; ++e) { x[2 * e] = __uint_as_float(ra[rr][e] << 16); x[2 * e + 1] = __uint_as_float(ra[rr][e] & 0xffff0000u); x[8 + 2 * e] = __uint_as_float(rc[rr][e] << 16); x[8 + 2 * e + 1] = __uint_as_float(rc[rr][e] & 0xffff0000u); }
                float ss = 0.f;
#pragma unroll
                for (int e = 0; e < 16; ++e) ss += x[e] * x[e];
#pragma unroll
                for (int o = 16; o >= 1; o >>= 1) ss += __shfl_xor(ss, o);
                const float rstd = rsqrtf(ss * (1.0f / 512.0f) + EPS);
#pragma unroll
                for (int e = 0; e < 16; ++e) x[e] *= rstd;
                if (t < T) {
                    bf16_t* orow = Ob + (size_t)t * DM + lane * 16;
                    *reinterpret_cast<u32x4*>(orow) = (u32x4){cvtpk(x[0], x[1]), cvtpk(x[2], x[3]), cvtpk(x[4], x[5]), cvtpk(x[6], x[7])};
                    *reinterpret_cast<u32x4*>(orow + 8) = (u32x4){cvtpk(x[8], x[9]), cvtpk(x[10], x[11]), cvtpk(x[12], x[13]), cvtpk(x[14], x[15])};
                }
            }
        }
    }
    SEAM(6);

    if (IN(7)) {
        int pm, pn;
        for (int i = 0; tile_next(i, G, bx, NMT, 4, pm, pn); ++i) {
            f32x4 acc[2][2][4][2];
            const int brow = pm * 256, bcol = pn * 256;
            gemm_core<true>(lds, Ob, DM, Woutt, DM, 16, brow, bcol, acc);
            EPI_GEOM
            int b, S, tok0; tokinfo(brow, b, S, tok0);
            const float* g1 = mod + b * 6144 + 2048;
            const int cl = wc * 32 + fq * 4;
            f32x4 gv[2][2], xv[2][2][2];
#pragma unroll
            for (int bj = 0; bj < 2; ++bj)
#pragma unroll
                for (int n = 0; n < 2; ++n) gv[bj][n] = *reinterpret_cast<const f32x4*>(g1 + bcol + bj * 128 + n * 16 + cl);
            { const float* xr = xrow(xp, xs, brow + wr * 64 + fr);
#pragma unroll
              for (int bj = 0; bj < 2; ++bj)
#pragma unroll
                  for (int n = 0; n < 2; ++n) xv[0][bj][n] = *reinterpret_cast<const f32x4*>(xr + bcol + bj * 128 + n * 16 + cl); }
#pragma unroll
            for (int it = 0; it < 8; ++it) {
                const int ai = it >> 2, m = it & 3;
                if (it + 1 < 8) {
                    const float* xr = xrow(xp, xs, brow + ((it + 1) >> 2) * 128 + wr * 64 + ((it + 1) & 3) * 16 + fr);
#pragma unroll
                    for (int bj = 0; bj < 2; ++bj)
#pragma unroll
                        for (int n = 0; n < 2; ++n) xv[(it + 1) & 1][bj][n] = *reinterpret_cast<const f32x4*>(xr + bcol + bj * 128 + n * 16 + cl);
                }
                const int row = brow + ai * 128 + wr * 64 + m * 16 + fr;
#pragma unroll
                for (int bj = 0; bj < 2; ++bj)
#pragma unroll
                    for (int n = 0; n < 2; ++n)
                        *reinterpret_cast<f32x4*>(out + (size_t)row * DM + bcol + bj * 128 + n * 16 + cl) = xv[it & 1][bj][n] * ALPHA + gv[bj][n] * acc[ai][bj][m][n];
                asm volatile("" ::: "memory");
            }
        }
    }
    SEAM(7);

    if (IN(8)) {
        const float* l1g = p.in[16]; const float* l1b = p.in[17];
        constexpr int NR = 4;
        for (int t0 = bx * 8 + wv; t0 < T; t0 += NR * G * 8) {
            f32x4 v[NR][4];
#pragma unroll
            for (int rr = 0; rr < NR; ++rr) {
                const int t = t0 + rr * G * 8; const float* orow = out + (size_t)(t < T ? t : t0) * DM;
#pragma unroll
                for (int c = 0; c < 4; ++c) v[rr][c] = *reinterpret_cast<const f32x4*>(orow + c * 256 + lane * 4);
            }
#pragma unroll
            for (int rr = 0; rr < NR; ++rr) {
                const int t = t0 + rr * G * 8;
                float* orow = out + (size_t)t * DM;
                float s = 0.f;
#pragma unroll
                for (int c = 0; c < 4; ++c) s += (v[rr][c][0] + v[rr][c][1]) + (v[rr][c][2] + v[rr][c][3]);
                float mean = wave_sum(s) * (1.0f / 1024.0f);
                float q = 0.f;
#pragma unroll
                for (int c = 0; c < 4; ++c) { v[rr][c] = v[rr][c] - mean; q += (v[rr][c][0] * v[rr][c][0] + v[rr][c][1] * v[rr][c][1]) + (v[rr][c][2] * v[rr][c][2] + v[rr][c][3] * v[rr][c][3]); }
                float rstd = rsqrtf(wave_sum(q) * (1.0f / 1024.0f) + EPS);
                s = 0.f;
#pragma unroll
                for (int c = 0; c < 4; ++c) {
                    const int col = c * 256 + lane * 4;
                    v[rr][c] = v[rr][c] * rstd * *reinterpret_cast<const f32x4*>(l1g + col) + *reinterpret_cast<const f32x4*>(l1b + col);
                    if (t < T) *reinterpret_cast<f32x4*>(orow + col) = v[rr][c];
                    s += (v[rr][c][0] + v[rr][c][1]) + (v[rr][c][2] + v[rr][c][3]);
                }
                mean = wave_sum(s) * (1.0f / 1024.0f);
                q = 0.f;
#pragma unroll
                for (int c = 0; c < 4; ++c) { v[rr][c] = v[rr][c] - mean; q += (v[rr][c][0] * v[rr][c][0] + v[rr][c][1] * v[rr][c][1]) + (v[rr][c][2] * v[rr][c][2] + v[rr][c][3] * v[rr][c][3]); }
                rstd = rsqrtf(wave_sum(q) * (1.0f / 1024.0f) + EPS);
                if (t < T) {
                    int b, S, tok0; tokinfo(t, b, S, tok0);
                    const float* md = mod + b * 6144;
#pragma unroll
                    for (int c = 0; c < 4; ++c) {
                        const int col = c * 256 + lane * 4;
                        const f32x4 sh = *reinterpret_cast<const f32x4*>(md + 3072 + col), sc = *reinterpret_cast<const f32x4*>(md + 4096 + col);
                        const f32x4 y = v[rr][c] * rstd * (sc + 1.0f) + sh;
                        *reinterpret_cast<u32x2*>(U + (size_t)t * DM + col) = (u32x2){cvtpk(y[0], y[1]), cvtpk(y[2], y[3])};
                    }
                }
            }
        }
    }
    SEAM(8);

    if (IN(9)) {
        int pm, pn;
        for (int i = 0; tile_next(i, G, bx, NMT, 22, pm, pn); ++i) {
            f32x4 acc[2][2][4][2];
            const int brow = pm * 256, bcol = pn * 256;
            gemm_core<true>(lds, U, DM, Wgut, DM, 16, brow, bcol, acc);
            EPI_GEOM
#pragma unroll
            for (int ai = 0; ai < 2; ++ai)
#pragma unroll
                for (int m = 0; m < 4; ++m) {
                    asm volatile("" ::: "memory"); const int row = brow + ai * 128 + wr * 64 + m * 16 + fr;
#pragma unroll
                    for (int n = 0; n < 2; ++n) {
                        const int c0 = pn * 128 + wc * 32 + n * 16 + fq * 4; const f32x4 g = acc[ai][0][m][n], uu = acc[ai][1][m][n];
                        float f[4];
#pragma unroll
                        for (int j = 0; j < 4; ++j) {
                            const float e = __builtin_amdgcn_exp2f(-LOG2E * g[j]);
                            f[j] = g[j] * __builtin_amdgcn_rcpf(1.0f + e) * uu[j];
                        }
                        *reinterpret_cast<u32x2*>(F + (size_t)row * DFF + c0) = (u32x2){cvtpk(f[0], f[1]), cvtpk(f[2], f[3])};
                    }
                }
        }
    }
    SEAM(9);

    if (IN(10)) {
        int pm, pn;
        for (int i = 0; tile_next(i, G, bx, NMT, 4, pm, pn); ++i) {
            f32x4 acc[2][2][4][2];
            const int brow = pm * 256, bcol = pn * 256;
            gemm_core<true>(lds, F, DFF, Wdnt, DFF, 44, brow, bcol, acc);
            EPI_GEOM
            int b, S, tok0; tokinfo(brow, b, S, tok0);
            const float* g2 = mod + b * 6144 + 5120;
            const int cl = wc * 32 + fq * 4;
            f32x4 gv[2][2], xv[2][2][2];
#pragma unroll
            for (int bj = 0; bj < 2; ++bj)
#pragma unroll
                for (int n = 0; n < 2; ++n) gv[bj][n] = *reinterpret_cast<const f32x4*>(g2 + bcol + bj * 128 + n * 16 + cl);
            { const float* xr = out + (size_t)(brow + wr * 64 + fr) * DM;
#pragma unroll
              for (int bj = 0; bj < 2; ++bj)
#pragma unroll
                  for (int n = 0; n < 2; ++n) xv[0][bj][n] = *reinterpret_cast<const f32x4*>(xr + bcol + bj * 128 + n * 16 + cl); }
#pragma unroll
            for (int it = 0; it < 8; ++it) {
                const int ai = it >> 2, m = it & 3;
                if (it + 1 < 8) {
                    const float* xr = out + (size_t)(brow + ((it + 1) >> 2) * 128 + wr * 64 + ((it + 1) & 3) * 16 + fr) * DM;
#pragma unroll
                    for (int bj = 0; bj < 2; ++bj)
#pragma unroll
                        for (int n = 0; n < 2; ++n) xv[(it + 1) & 1][bj][n] = *reinterpret_cast<const f32x4*>(xr + bcol + bj * 128 + n * 16 + cl);
                }
                const int row = brow + ai * 128 + wr * 64 + m * 16 + fr;
#pragma unroll
                for (int bj = 0; bj < 2; ++bj)
#pragma unroll
                    for (int n = 0; n < 2; ++n)
                        *reinterpret_cast<f32x4*>(out + (size_t)row * DM + bcol + bj * 128 + n * 16 + cl) = xv[it & 1][bj][n] * ALPHA + gv[bj][n] * acc[ai][bj][m][n];
                asm volatile("" ::: "memory");
            }
        }
    }
    SEAM(10);

    if (IN(11)) {
        const float* l2g = p.in[21]; const float* l2b = p.in[22];
        constexpr int NR = 4;
        for (int t0 = bx * 8 + wv; t0 < T; t0 += NR * G * 8) {
            f32x4 v[NR][4];
#pragma unroll
            for (int rr = 0; rr < NR; ++rr) {
                const int t = t0 + rr * G * 8; const float* orow = out + (size_t)(t < T ? t : t0) * DM;
#pragma unroll
                for (int c = 0; c < 4; ++c) v[rr][c] = *reinterpret_cast<const f32x4*>(orow + c * 256 + lane * 4);
            }
#pragma unroll
            for (int rr = 0; rr < NR; ++rr) {
                const int t = t0 + rr * G * 8;
                float* orow = out + (size_t)t * DM;
                float s = 0.f;
#pragma unroll
                for (int c = 0; c < 4; ++c) s += (v[rr][c][0] + v[rr][c][1]) + (v[rr][c][2] + v[rr][c][3]);
                const float mean = wave_sum(s) * (1.0f / 1024.0f);
                float q = 0.f;
#pragma unroll
                for (int c = 0; c < 4; ++c) { v[rr][c] = v[rr][c] - mean; q += (v[rr][c][0] * v[rr][c][0] + v[rr][c][1] * v[rr][c][1]) + (v[rr][c][2] * v[rr][c][2] + v[rr][c][3] * v[rr][c][3]); }
                const float rstd = rsqrtf(wave_sum(q) * (1.0f / 1024.0f) + EPS);
                if (t < T) {
#pragma unroll
                    for (int c = 0; c < 4; ++c) {
                        const int col = c * 256 + lane * 4;
                        *reinterpret_cast<f32x4*>(orow + col) = v[rr][c] * rstd * *reinterpret_cast<const f32x4*>(l2g + col) + *reinterpret_cast<const f32x4*>(l2b + col);
                    }
                }
            }
        }
    }
#undef IN
#undef SEAM
}

extern "C" void kernel_launch(void* const* d_in, const int* in_sizes, int n_in, void* d_out, int out_size, void* d_ws, size_t ws_size, hipStream_t stream) {
    static int grid_blocks = 0;
    if (grid_blocks == 0) {
        if (n_in != 23 || out_size != T * DM || ws_size < WS_END) { fprintf(stderr, "kernel_launch: unexpected shapes (n_in %d out %d ws %zu)\n", n_in, out_size, ws_size); grid_blocks = -1; return; }
        int dev = 0, cus = 0, per_cu = 0;
        hipGetDevice(&dev);
        hipDeviceGetAttribute(&cus, hipDeviceAttributeMultiprocessorCount, dev);
        if (hipFuncSetAttribute((const void*)fwd_kernel, hipFuncAttributeMaxDynamicSharedMemorySize, LDS_BYTES) != hipSuccess) { fprintf(stderr, "kernel_launch: hipFuncSetAttribute failed\n"); grid_blocks = -1; return; }
        if (hipOccupancyMaxActiveBlocksPerMultiprocessor(&per_cu, (const void*)fwd_kernel, 512, LDS_BYTES) != hipSuccess || per_cu < 1) { fprintf(stderr, "kernel_launch: occupancy query says %d\n", per_cu); per_cu = 1; }
        (void)hipGetLastError();
        grid_blocks = cus;
    }
    if (grid_blocks < 0) return;
    if (hipMemsetAsync((char*)d_ws + WS_BAR, 0, XCD_BAR_WORDS * 4, stream) != hipSuccess) { fprintf(stderr, "kernel_launch: hipMemsetAsync failed\n"); return; }
    Params p{};
    for (int i = 0; i < 23; ++i) p.in[i] = (const float*)d_in[i];
    p.out = (float*)d_out; p.ws = (unsigned char*)d_ws; p.lo = 0; p.hi = NPHASE;
    void* args[] = {&p};
    hipError_t e = hipLaunchCooperativeKernel((const void*)fwd_kernel, dim3(grid_blocks), dim3(512), args, LDS_BYTES, stream);
    if (e != hipSuccess) fprintf(stderr, "kernel_launch: cooperative launch failed: %s (grid %d)\n", hipGetErrorString(e), grid_blocks);
}
```

```cpp
#include <hip/hip_runtime.h>
#include <hip/hip_cooperative_groups.h>
#include <cstdio>
#include <cstdint>
namespace cg = cooperative_groups;

typedef unsigned short bf16_t;
typedef short bf16x8 __attribute__((ext_vector_type(8)));
typedef float f32x4 __attribute__((ext_vector_type(4)));
typedef float f32x16 __attribute__((ext_vector_type(16)));
typedef unsigned u32x4 __attribute__((ext_vector_type(4)));
typedef unsigned u32x2 __attribute__((ext_vector_type(2)));
typedef float f32x2_t __attribute__((ext_vector_type(2)));
typedef __bf16 bf16x2_t __attribute__((ext_vector_type(2)));

constexpr int DM = 1024, TP = 8 * 2048, TSMP = 8 * 8192, T = TP + TSMP;
constexpr int HP = 1280;
constexpr int DFF = 2816;
constexpr int NMT = T / 256;
constexpr float EPS = 1e-6f;
constexpr float ALPHA = 1.189207115002721f;
constexpr float LOG2E = 1.4426950408889634f;
constexpr float C2A = 0.125f * LOG2E;
constexpr float C2M = 0.10206207261596575f * LOG2E;

constexpr size_t MiB = 1u << 20;
constexpr size_t WS_W1T = 0;
constexpr size_t WS_WUQT = 3 * MiB;
constexpr size_t WS_WUKVT = 4 * MiB;
constexpr size_t WS_WOUTT = 5 * MiB;
constexpr size_t WS_WGUT = 7 * MiB;
constexpr size_t WS_WDNT = 18 * MiB;
constexpr size_t WS_MOD = 24 * MiB;
constexpr size_t WS_COSA = 25 * MiB;
constexpr size_t WS_SINA = 26 * MiB;
constexpr size_t WS_COSB = 27 * MiB;
constexpr size_t WS_SINB = 28 * MiB;
constexpr size_t WS_RSQ = 29 * MiB;
constexpr size_t WS_RSKV = 30 * MiB;
constexpr size_t WS_BAR = 31 * MiB;
constexpr size_t WS_U = 32 * MiB;
constexpr size_t WS_H = 192 * MiB;
constexpr size_t WS_O = 192 * MiB;
constexpr size_t WS_QA = 392 * MiB;
constexpr size_t WS_KA = 472 * MiB;
constexpr size_t WS_VTA = 492 * MiB;
constexpr size_t WS_QM = 512 * MiB;
constexpr size_t WS_KN = 632 * MiB;
constexpr size_t WS_KPE = 712 * MiB;
constexpr size_t WS_VTM = 717 * MiB;
constexpr size_t WS_F = 192 * MiB;
constexpr size_t WS_PQ = 800 * MiB;
constexpr size_t WS_PKV = 802 * MiB;
constexpr size_t WS_END = 804 * MiB;

constexpr int LDS_XST = 147456;
constexpr int LDS_BYTES = LDS_XST + 256;
constexpr int NPHASE = 12;

struct Params {
    const float* in[23];
    float* out;
    unsigned char* ws;
    int lo, hi;
};

__device__ __forceinline__ unsigned cvtpk(float lo, float hi) { f32x2_t v = {lo, hi}; bf16x2_t b = __builtin_convertvector(v, bf16x2_t); return __builtin_bit_cast(unsigned, b); }
__device__ __forceinline__ bf16_t f2bf(float f) { return (bf16_t)(cvtpk(f, 0.f) & 0xffffu); }
__device__ __forceinline__ float bf2f(unsigned short h) { return __uint_as_float(((unsigned)h) << 16); }
__device__ __forceinline__ float wave_sum(float v) {
#pragma unroll
    for (int o = 32; o >= 1; o >>= 1) v += __shfl_xor(v, o);
    return v;
}
__device__ __forceinline__ void tokinfo(int t, int& b, int& S, int& tok0) {
    if (t < TP) { b = t >> 11; S = 2048; tok0 = b << 11; }
    else { const int u = t - TP; const int bb = u >> 13; b = 8 + bb; S = 8192; tok0 = TP + (bb << 13); }
}
__device__ __forceinline__ const float* xrow(const float* xp, const float* xs, int t) {
    return t < TP ? xp + (size_t)t * DM : xs + (size_t)(t - TP) * DM;
}

constexpr int HTB = 128 * 64 * 2;
__device__ __forceinline__ int lds_byte(int r, int c) {
    const int st = (r >> 4) * 2 + (c >> 5), rr = r & 15, cc = c & 31, ob = rr * 64 + cc * 2;
    return st * 1024 + (ob ^ (((ob >> 9) & 1) << 5));
}
__device__ __forceinline__ void stage_rc(int b, int& R, int& C) {
    const int st = b / 1024, sb = b % 1024, swz = sb ^ (((sb >> 9) & 1) << 5);
    R = (st >> 1) * 16 + swz / 64; C = (st & 1) * 32 + (swz % 64) / 2;
}
__device__ __forceinline__ bool tile_next(int i, int G, int c, int nM, int nN, int& pm, int& pn) {
    const int nwg = nM * nN; const long L = (long)i * G + c; if (L >= nwg) return false;
    int wgid = (int)L;
    if ((G & 7) == 0) { const int q = nwg / 8, r = nwg % 8, xcd = wgid % 8, off = wgid / 8; wgid = (xcd < r ? xcd * (q + 1) : r * (q + 1) + (xcd - r) * q) + off; }
    const int nig = 8 * nN, gid = wgid / nig, fm = gid * 8, gsz = (nM - fm) < 8 ? (nM - fm) : 8;
    pm = fm + ((wgid % nig) % gsz); pn = (wgid % nig) / gsz; return true;
}

#define WAIT_V(n) asm volatile("s_waitcnt vmcnt(" #n ")" ::: "memory")
#define WAIT_L(n) asm volatile("s_waitcnt lgkmcnt(" #n ")" ::: "memory")
#define BAR __builtin_amdgcn_s_barrier()
#define SCHED __builtin_amdgcn_sched_barrier(0)

__device__ __forceinline__ void glds16(const void* sbase, unsigned voff, unsigned ldsdst) {
    unsigned keep;
    asm volatile("s_mov_b32 %0, m0\n\ts_mov_b32 m0, %3\n\ts_nop 0\n\tglobal_load_lds_dwordx4 %2, %1\n\ts_mov_b32 m0, %0"
                 : "=&s"(keep) : "s"(sbase), "v"(voff), "s"(ldsdst) : "memory");
}
template <bool TR>
__device__ __forceinline__ void gemm_core(unsigned char* shm, const bf16_t* __restrict__ A, int lda, const bf16_t* __restrict__ Bt, int ldb,
                                          int nt, int brow, int bcol, f32x4 (&acc)[2][2][4][2]) {
    const int wid = threadIdx.x >> 6, lane = threadIdx.x & 63, wr = wid >> 2, wc = wid & 3, fr = lane & 15, fq = lane >> 4;
    int sr0, sc0; stage_rc(threadIdx.x * 16, sr0, sc0);
    const unsigned offA = (unsigned)(sr0 * lda + sc0) * 2u, offB = (unsigned)(sr0 * ldb + sc0) * 2u;
    const unsigned ldsw = (unsigned)(uintptr_t)shm + (unsigned)__builtin_amdgcn_readfirstlane(wid) * 1024u;
#define SA(b, h) (shm + ((b) * 2 + (h)) * HTB)
#define SB(b, h) (shm + (4 + (b) * 2 + (h)) * HTB)
#define SAO(b, h) (((b) * 2 + (h)) * HTB)
#define SBO(b, h) ((4 + (b) * 2 + (h)) * HTB)
#define STAGE(PO, BASE, LD, VO, br, kt) do { \
        const char* b0_ = (const char*)(BASE) + ((long)(br) * (LD) + (long)(kt) * 64) * 2; \
        glds16(b0_, VO, ldsw + (PO)); glds16(b0_ + (long)(LD) * 128, VO, ldsw + (PO) + 8192u); } while (0)
#define LDA(dst, b, h) for (int m = 0; m < 4; ++m) for (int k = 0; k < 2; ++k) \
        dst[m][k] = *reinterpret_cast<const bf16x8*>(SA(b, h) + lds_byte(wr * 64 + m * 16 + fr, k * 32 + fq * 8))
#define LDB(dst, b, h) for (int n = 0; n < 2; ++n) for (int k = 0; k < 2; ++k) \
        dst[n][k] = *reinterpret_cast<const bf16x8*>(SB(b, h) + lds_byte(wc * 32 + n * 16 + fr, k * 32 + fq * 8))
#define MMA(ai, bj, At_, Bt_) do { __builtin_amdgcn_s_setprio(1); \
        for (int m = 0; m < 4; ++m) for (int n = 0; n < 2; ++n) for (int k = 0; k < 2; ++k) \
            acc[ai][bj][m][n] = TR ? __builtin_amdgcn_mfma_f32_16x16x32_bf16(Bt_[n][k], At_[m][k], acc[ai][bj][m][n], 0, 0, 0) \
                                   : __builtin_amdgcn_mfma_f32_16x16x32_bf16(At_[m][k], Bt_[n][k], acc[ai][bj][m][n], 0, 0, 0); \
        __builtin_amdgcn_s_setprio(0); } while (0)
    bf16x8 At[4][2], B0[2][2], B1[2][2];
#pragma unroll
    for (int a = 0; a < 2; ++a)
#pragma unroll
        for (int b = 0; b < 2; ++b)
#pragma unroll
            for (int m = 0; m < 4; ++m)
#pragma unroll
                for (int n = 0; n < 2; ++n) acc[a][b][m][n] = (f32x4){0.f, 0.f, 0.f, 0.f};
    STAGE(SBO(0, 0), Bt, ldb, offB, bcol, 0); STAGE(SAO(0, 0), A, lda, offA, brow, 0);
    STAGE(SBO(0, 1), Bt, ldb, offB, bcol + 128, 0); STAGE(SAO(0, 1), A, lda, offA, brow + 128, 0);
    if (wr == 1) BAR;
    WAIT_V(4); BAR;
    STAGE(SBO(1, 0), Bt, ldb, offB, bcol, 1); STAGE(SAO(1, 0), A, lda, offA, brow, 1); STAGE(SBO(1, 1), Bt, ldb, offB, bcol + 128, 1);
    WAIT_V(6); BAR;
    for (int t = 0; t < nt - 2; t += 2) {
        LDB(B0, 0, 0); SCHED; LDA(At, 0, 0); STAGE(SAO(1, 1), A, lda, offA, brow + 128, t + 1);
        WAIT_L(8); BAR; WAIT_L(0); MMA(0, 0, At, B0); BAR; SCHED;
        LDB(B1, 0, 1); STAGE(SBO(0, 0), Bt, ldb, offB, bcol, t + 2);
        BAR; WAIT_L(0); MMA(0, 1, At, B1); BAR;
        LDA(At, 0, 1); STAGE(SAO(0, 0), A, lda, offA, brow, t + 2);
        BAR; WAIT_L(0); MMA(1, 0, At, B0); BAR; SCHED;
        STAGE(SBO(0, 1), Bt, ldb, offB, bcol + 128, t + 2);
        WAIT_V(6); BAR; MMA(1, 1, At, B1); BAR;
        LDB(B0, 1, 0); SCHED; LDA(At, 1, 0); STAGE(SAO(0, 1), A, lda, offA, brow + 128, t + 2);
        WAIT_L(8); BAR; WAIT_L(0); MMA(0, 0, At, B0); BAR; SCHED;
        LDB(B1, 1, 1); STAGE(SBO(1, 0), Bt, ldb, offB, bcol, t + 3);
        BAR; WAIT_L(0); MMA(0, 1, At, B1); BAR;
        LDA(At, 1, 1); STAGE(SAO(1, 0), A, lda, offA, brow, t + 3);
        BAR; WAIT_L(0); MMA(1, 0, At, B0); BAR; SCHED;
        STAGE(SBO(1, 1), Bt, ldb, offB, bcol + 128, t + 3);
        WAIT_V(6); BAR; MMA(1, 1, At, B1); BAR;
    }
    { LDB(B0, 0, 0); LDA(At, 0, 0); STAGE(SAO(1, 1), A, lda, offA, brow + 128, nt - 1);
      BAR; WAIT_L(0); MMA(0, 0, At, B0); BAR;
      LDB(B1, 0, 1); BAR; WAIT_L(0); MMA(0, 1, At, B1); BAR;
      LDA(At, 0, 1); WAIT_V(4); BAR; WAIT_L(0); MMA(1, 0, At, B0); MMA(1, 1, At, B1); BAR; }
    { LDB(B0, 1, 0); LDA(At, 1, 0); WAIT_V(2); BAR; WAIT_L(0); MMA(0, 0, At, B0); BAR;
      LDB(B1, 1, 1); WAIT_V(0); BAR; WAIT_L(0); MMA(0, 1, At, B1); BAR;
      LDA(At, 1, 1); BAR; WAIT_L(0); MMA(1, 0, At, B0); MMA(1, 1, At, B1); BAR; }
    if (wr == 0) BAR;
#undef SA
#undef SB
#undef SAO
#undef SBO
#undef STAGE
#undef LDA
#undef LDB
#undef MMA
}

#define EPI_GEOM int tid_e = threadIdx.x; asm volatile("" : "+v"(tid_e)); const int wid = tid_e >> 6, lane = tid_e & 63, wr = wid >> 2, wc = wid & 3, fr = lane & 15, fq = lane >> 4; (void)wr; (void)wc; (void)fr; (void)fq;

__device__ __forceinline__ float dot2ones(unsigned pk, float acc) {
    return __builtin_amdgcn_fdot2_f32_bf16(__builtin_bit_cast(bf16x2_t, pk), __builtin_bit_cast(bf16x2_t, 0x3F803F80u), acc, false);
}
__device__ __forceinline__ int kperm(int i) { return (i & ~12) | ((i & 4) << 1) | ((i & 8) >> 1); }

__device__ __forceinline__ float xmax(float v) {
    auto rr = __builtin_amdgcn_permlane32_swap(__float_as_uint(v), __float_as_uint(v), false, false);
    return fmaxf(__uint_as_float(rr[0]), __uint_as_float(rr[1]));
}
__device__ __forceinline__ float xsum(float v) {
    auto rr = __builtin_amdgcn_permlane32_swap(__float_as_uint(v), __float_as_uint(v), false, false);
    return __uint_as_float(rr[0]) + __uint_as_float(rr[1]);
}
template <int DQ>
__device__ __forceinline__ void attn_unit2(unsigned char* shm, const bf16_t* __restrict__ Q0, const bf16_t* __restrict__ Q1, int ldq,
                                           const bf16_t* __restrict__ K1, int ldk1, const bf16_t* __restrict__ K2, const bf16_t* __restrict__ Vt, int S,
                                           bf16_t* __restrict__ O0, bf16_t* __restrict__ O1) {
    constexpr int KP = DQ * 2 + 16, VP = 144, VOFF = 64 * KP, BUFB = VOFF + 64 * VP, ND0 = DQ / 16;
    constexpr float THR = 6.0f;
    const int tid = threadIdx.x, lane = tid & 63, wid = tid >> 6, r32 = lane & 31, hi = lane >> 5;
    const int skey = tid >> 3, sch = tid & 7;
    const int pkey = tid >> 2, pch = tid & 3;
    const bf16_t* kg = K1 + (size_t)skey * ldk1 + sch * 8;
    const bf16_t* pg = (DQ == 96) ? (K2 + (size_t)pkey * 32 + pch * 8) : nullptr;
    const bf16_t* vg = Vt + (size_t)skey * S + sch * 8;
    const int kst = skey * KP + sch * 16, pst = pkey * KP + 128 + pch * 16, vst = VOFF + skey * VP + sch * 16;
    const int qlo = 49152 + wid * (2 * 6 * 1024) + lane * 16;
    { const bf16_t* qp0 = Q0 + (size_t)(wid * 32 + r32) * ldq + hi * 8; const bf16_t* qp1 = Q1 + (size_t)(wid * 32 + r32) * ldq + hi * 8;
      {
#pragma unroll
          for (int d0 = 0; d0 < ND0; ++d0) {
              *reinterpret_cast<bf16x8*>(shm + qlo + d0 * 1024) = *reinterpret_cast<const bf16x8*>(qp0 + d0 * 16);
              *reinterpret_cast<bf16x8*>(shm + qlo + (6 + d0) * 1024) = *reinterpret_cast<const bf16x8*>(qp1 + d0 * 16);
          }
      } }
    const int kfo = kperm(r32) * KP + hi * 16;
    const int vfo = VOFF + r32 * VP + hi * 16;
    const int NT = S / 64;
    u32x4 kreg, preg, vreg;
    kreg = *reinterpret_cast<const u32x4*>(kg); vreg = *reinterpret_cast<const u32x4*>(vg);
    if (DQ == 96) { if (tid < 256) preg = *reinterpret_cast<const u32x4*>(pg); }
    __syncthreads();
    *reinterpret_cast<u32x4*>(shm + kst) = kreg; *reinterpret_cast<u32x4*>(shm + vst) = vreg;
    if (DQ == 96) { if (tid < 256) *reinterpret_cast<u32x4*>(shm + pst) = preg; }
    __syncthreads();
    float m_run[2] = {0.f, 0.f}, l_run[2] = {0.f, 0.f};
    f32x16 zc;
#pragma unroll
    for (int r = 0; r < 16; ++r) zc[r] = 0.f;
    f32x16 o[2][2];
#pragma unroll
    for (int sb = 0; sb < 2; ++sb)
#pragma unroll
        for (int r = 0; r < 16; ++r) { o[sb][0][r] = 0.f; o[sb][1][r] = 0.f; }
    for (int t = 0; t < NT; ++t) {
        const unsigned char* buf = shm + (t & 1) * BUFB;
        if (t + 1 < NT) {
            kreg = *reinterpret_cast<const u32x4*>(kg + (size_t)(t + 1) * 64 * ldk1);
            vreg = *reinterpret_cast<const u32x4*>(vg + (t + 1) * 64);
            if (DQ == 96) { if (tid < 256) preg = *reinterpret_cast<const u32x4*>(pg + (size_t)(t + 1) * 64 * 32); }
        }
        const bool first = (t == 0);
        if (DQ == 64) {
            f32x16 p[2][2];
#pragma unroll
            for (int h = 0; h < 2; ++h) {
                bf16x8 kf[4], qa[2], qb[2];
#pragma unroll
                for (int dd = 0; dd < 2; ++dd) {
                    kf[2 * dd] = *reinterpret_cast<const bf16x8*>(buf + kfo + (2 * h + dd) * 32);
                    kf[2 * dd + 1] = *reinterpret_cast<const bf16x8*>(buf + kfo + 32 * KP + (2 * h + dd) * 32);
                    qa[dd] = *reinterpret_cast<const bf16x8*>(shm + qlo + (2 * h + dd) * 1024);
                    qb[dd] = *reinterpret_cast<const bf16x8*>(shm + qlo + (6 + 2 * h + dd) * 1024);
                }
                __builtin_amdgcn_sched_barrier(0);
                if (h == 0) {
                    p[0][0] = __builtin_amdgcn_mfma_f32_32x32x16_bf16(kf[0], qa[0], zc, 0, 0, 0);
                    p[0][1] = __builtin_amdgcn_mfma_f32_32x32x16_bf16(kf[1], qa[0], zc, 0, 0, 0);
                    p[1][0] = __builtin_amdgcn_mfma_f32_32x32x16_bf16(kf[0], qb[0], zc, 0, 0, 0);
                    p[1][1] = __builtin_amdgcn_mfma_f32_32x32x16_bf16(kf[1], qb[0], zc, 0, 0, 0);
                } else {
                    p[0][0] = __builtin_amdgcn_mfma_f32_32x32x16_bf16(kf[0], qa[0], p[0][0], 0, 0, 0);
                    p[0][1] = __builtin_amdgcn_mfma_f32_32x32x16_bf16(kf[1], qa[0], p[0][1], 0, 0, 0);
                    p[1][0] = __builtin_amdgcn_mfma_f32_32x32x16_bf16(kf[0], qb[0], p[1][0], 0, 0, 0);
                    p[1][1] = __builtin_amdgcn_mfma_f32_32x32x16_bf16(kf[1], qb[0], p[1][1], 0, 0, 0);
                }
                p[0][0] = __builtin_amdgcn_mfma_f32_32x32x16_bf16(kf[2], qa[1], p[0][0], 0, 0, 0);
                p[0][1] = __builtin_amdgcn_mfma_f32_32x32x16_bf16(kf[3], qa[1], p[0][1], 0, 0, 0);
                p[1][0] = __builtin_amdgcn_mfma_f32_32x32x16_bf16(kf[2], qb[1], p[1][0], 0, 0, 0);
                p[1][1] = __builtin_amdgcn_mfma_f32_32x32x16_bf16(kf[3], qb[1], p[1][1], 0, 0, 0);
                __builtin_amdgcn_sched_barrier(0);
            }
            bf16x8 vf[8];
#pragma unroll
            for (int ks = 0; ks < 4; ++ks) {
                vf[2 * ks] = *reinterpret_cast<const bf16x8*>(buf + vfo + ks * 32);
                vf[2 * ks + 1] = *reinterpret_cast<const bf16x8*>(buf + vfo + 32 * VP + ks * 32);
            }
            __builtin_amdgcn_sched_barrier(0);
            float rm[2];
#pragma unroll
            for (int sb = 0; sb < 2; ++sb) {
                const f32x16& p0 = p[sb][0]; const f32x16& p1 = p[sb][1];
                float a0 = __builtin_fmaxf(__builtin_fmaxf(p0[0], p0[1]), p1[0]), a1 = __builtin_fmaxf(__builtin_fmaxf(p0[2], p0[3]), p1[1]);
                a0 = __builtin_fmaxf(__builtin_fmaxf(a0, p1[2]), p1[3]);
#pragma unroll
                for (int r = 4; r < 16; r += 4) {
                    a0 = __builtin_fmaxf(__builtin_fmaxf(a0, p0[r]), p0[r + 1]); a1 = __builtin_fmaxf(__builtin_fmaxf(a1, p0[r + 2]), p0[r + 3]);
                    a0 = __builtin_fmaxf(__builtin_fmaxf(a0, p1[r]), p1[r + 1]); a1 = __builtin_fmaxf(__builtin_fmaxf(a1, p1[r + 2]), p1[r + 3]);
                }
                rm[sb] = xmax(__builtin_fmaxf(a0, a1));
            }
            {   const float rmc = fmaxf(rm[0], rm[1]);
                if (first || __any(rmc > THR)) {
                    const float dl = first ? rmc : fmaxf(rmc, 0.f);
                    const float al = first ? 0.f : __builtin_amdgcn_exp2f(-dl);
                    m_run[0] += dl; l_run[0] *= al; l_run[1] *= al;
#pragma unroll
                    for (int r = 0; r < 16; ++r) { zc[r] -= dl;
                        o[0][0][r] *= al; o[0][1][r] *= al; o[1][0][r] *= al; o[1][1][r] *= al;
                        p[0][0][r] -= dl; p[0][1][r] -= dl; p[1][0][r] -= dl; p[1][1][r] -= dl; }
                }
            }
#define SM_STEP(SB, PW) do { f32x16& p0 = p[SB][0]; f32x16& p1 = p[SB][1]; float ls0 = 0.f, ls1 = 0.f; \
                _Pragma("unroll") for (int r = 0; r < 16; ++r) { p0[r] = __builtin_amdgcn_exp2f(p0[r]); p1[r] = __builtin_amdgcn_exp2f(p1[r]); } \
                PW[0] = (u32x4){cvtpk(p0[0], p0[1]), cvtpk(p0[2], p0[3]), cvtpk(p0[4], p0[5]), cvtpk(p0[6], p0[7])}; \
                PW[1] = (u32x4){cvtpk(p0[8], p0[9]), cvtpk(p0[10], p0[11]), cvtpk(p0[12], p0[13]), cvtpk(p0[14], p0[15])}; \
                PW[2] = (u32x4){cvtpk(p1[0], p1[1]), cvtpk(p1[2], p1[3]), cvtpk(p1[4], p1[5]), cvtpk(p1[6], p1[7])}; \
                PW[3] = (u32x4){cvtpk(p1[8], p1[9]), cvtpk(p1[10], p1[11]), cvtpk(p1[12], p1[13]), cvtpk(p1[14], p1[15])}; \
                _Pragma("unroll") for (int k = 0; k < 4; ++k) { ls0 = dot2ones(PW[k][0], ls0); ls1 = dot2ones(PW[k][1], ls1); ls0 = dot2ones(PW[k][2], ls0); ls1 = dot2ones(PW[k][3], ls1); } \
                l_run[SB] += ls0 + ls1; } while (0)
            u32x4 pwa[4], pwb[4];
            SM_STEP(0, pwa);
            __builtin_amdgcn_sched_barrier(0);
#pragma unroll
            for (int ks = 0; ks < 4; ++ks) {
                const bf16x8 pb = __builtin_bit_cast(bf16x8, pwa[ks]);
                o[0][0] = __builtin_amdgcn_mfma_f32_32x32x16_bf16(vf[2 * ks], pb, o[0][0], 0, 0, 0);
                o[0][1] = __builtin_amdgcn_mfma_f32_32x32x16_bf16(vf[2 * ks + 1], pb, o[0][1], 0, 0, 0);
            }
            SM_STEP(1, pwb);
#pragma unroll
            for (int g = 0; g < 8; ++g) { __builtin_amdgcn_sched_group_barrier(0x008, 1, 0); __builtin_amdgcn_sched_group_barrier(0x002 | 0x400, 14, 0); }
            __builtin_amdgcn_sched_barrier(0);
#undef SM_STEP
#pragma unroll
            for (int ks = 0; ks < 4; ++ks) {
                const bf16x8 pb = __builtin_bit_cast(bf16x8, pwb[ks]);
                o[1][0] = __builtin_amdgcn_mfma_f32_32x32x16_bf16(vf[2 * ks], pb, o[1][0], 0, 0, 0);
                o[1][1] = __builtin_amdgcn_mfma_f32_32x32x16_bf16(vf[2 * ks + 1], pb, o[1][1], 0, 0, 0);
            }
            __builtin_amdgcn_sched_barrier(0);
        } else {
#define QK_STEP(SB, P0, P1) do { \
            _Pragma("unroll") for (int kh = 0; kh < 2; ++kh) { \
                bf16x8 kf[6]; \
                _Pragma("unroll") for (int dd = 0; dd < 3; ++dd) { \
                    kf[2 * dd] = *reinterpret_cast<const bf16x8*>(buf + kfo + (kh * 3 + dd) * 32); \
                    kf[2 * dd + 1] = *reinterpret_cast<const bf16x8*>(buf + kfo + 32 * KP + (kh * 3 + dd) * 32); } \
                __builtin_amdgcn_sched_barrier(0); \
                _Pragma("unroll") for (int dd = 0; dd < 3; ++dd) { \
                    const bf16x8 qf = *reinterpret_cast<const bf16x8*>(shm + qlo + ((SB) * 6 + kh * 3 + dd) * 1024); \
                    if (kh == 0 && dd == 0) { f32x16 z; { const float nm = -m_run[SB]; _Pragma("unroll") for (int r = 0; r < 16; ++r) z[r] = nm; } \
                        P0 = __builtin_amdgcn_mfma_f32_32x32x16_bf16(kf[0], qf, z, 0, 0, 0); P1 = __builtin_amdgcn_mfma_f32_32x32x16_bf16(kf[1], qf, z, 0, 0, 0); } \
                    else { P0 = __builtin_amdgcn_mfma_f32_32x32x16_bf16(kf[2 * dd], qf, P0, 0, 0, 0); P1 = __builtin_amdgcn_mfma_f32_32x32x16_bf16(kf[2 * dd + 1], qf, P1, 0, 0, 0); } } \
                __builtin_amdgcn_sched_barrier(0); } } while (0)
#define ROWMAX_RESCALE(SB, P0, P1) do { \
            float a0 = __builtin_fmaxf(__builtin_fmaxf(P0[0], P0[1]), P1[0]), a1 = __builtin_fmaxf(__builtin_fmaxf(P0[2], P0[3]), P1[1]); \
            a0 = __builtin_fmaxf(__builtin_fmaxf(a0, P1[2]), P1[3]); \
            _Pragma("unroll") for (int r = 4; r < 16; r += 4) { \
                a0 = __builtin_fmaxf(__builtin_fmaxf(a0, P0[r]), P0[r + 1]); a1 = __builtin_fmaxf(__builtin_fmaxf(a1, P0[r + 2]), P0[r + 3]); \
                a0 = __builtin_fmaxf(__builtin_fmaxf(a0, P1[r]), P1[r + 1]); a1 = __builtin_fmaxf(__builtin_fmaxf(a1, P1[r + 2]), P1[r + 3]); } \
            const float rm = xmax(__builtin_fmaxf(a0, a1));   \
            if (first || __any(rm > THR)) { \
                const float dl = first ? rm : fmaxf(rm, 0.f); const float al = first ? 0.f : __builtin_amdgcn_exp2f(-dl); \
                m_run[SB] += dl; l_run[SB] *= al; \
                _Pragma("unroll") for (int r = 0; r < 16; ++r) { o[SB][0][r] *= al; o[SB][1][r] *= al; P0[r] -= dl; P1[r] -= dl; } } } while (0)
#define SM_STEP(SB, P0, P1, PW) do { float ls0 = 0.f, ls1 = 0.f; \
            _Pragma("unroll") for (int r = 0; r < 16; ++r) { P0[r] = __builtin_amdgcn_exp2f(P0[r]); P1[r] = __builtin_amdgcn_exp2f(P1[r]); } \
            PW[0] = (u32x4){cvtpk(P0[0], P0[1]), cvtpk(P0[2], P0[3]), cvtpk(P0[4], P0[5]), cvtpk(P0[6], P0[7])}; \
            PW[1] = (u32x4){cvtpk(P0[8], P0[9]), cvtpk(P0[10], P0[11]), cvtpk(P0[12], P0[13]), cvtpk(P0[14], P0[15])}; \
            PW[2] = (u32x4){cvtpk(P1[0], P1[1]), cvtpk(P1[2], P1[3]), cvtpk(P1[4], P1[5]), cvtpk(P1[6], P1[7])}; \
            PW[3] = (u32x4){cvtpk(P1[8], P1[9]), cvtpk(P1[10], P1[11]), cvtpk(P1[12], P1[13]), cvtpk(P1[14], P1[15])}; \
            _Pragma("unroll") for (int k = 0; k < 4; ++k) { ls0 = dot2ones(PW[k][0], ls0); ls1 = dot2ones(PW[k][1], ls1); ls0 = dot2ones(PW[k][2], ls0); ls1 = dot2ones(PW[k][3], ls1); } \
            l_run[SB] += ls0 + ls1; } while (0)
            u32x4 pwa[4], pwb[4];
            {
                f32x16 pa0, pa1;
                QK_STEP(0, pa0, pa1);
                ROWMAX_RESCALE(0, pa0, pa1);
                SM_STEP(0, pa0, pa1, pwa);
                __builtin_amdgcn_sched_barrier(0);
            }
            f32x16 pb0, pb1;
            QK_STEP(1, pb0, pb1);
            bf16x8 vf[8];
#pragma unroll
            for (int ks = 0; ks < 4; ++ks) {
                vf[2 * ks] = *reinterpret_cast<const bf16x8*>(buf + vfo + ks * 32);
                vf[2 * ks + 1] = *reinterpret_cast<const bf16x8*>(buf + vfo + 32 * VP + ks * 32);
            }
            ROWMAX_RESCALE(1, pb0, pb1);
            __builtin_amdgcn_sched_barrier(0);
#pragma unroll
            for (int ks = 0; ks < 4; ++ks) {
                const bf16x8 pb = __builtin_bit_cast(bf16x8, pwa[ks]);
                o[0][0] = __builtin_amdgcn_mfma_f32_32x32x16_bf16(vf[2 * ks], pb, o[0][0], 0, 0, 0);
                o[0][1] = __builtin_amdgcn_mfma_f32_32x32x16_bf16(vf[2 * ks + 1], pb, o[0][1], 0, 0, 0);
            }
            SM_STEP(1, pb0, pb1, pwb);
#pragma unroll
            for (int g = 0; g < 8; ++g) { __builtin_amdgcn_sched_group_barrier(0x008, 1, 0); __builtin_amdgcn_sched_group_barrier(0x002 | 0x400, 14, 0); }
            __builtin_amdgcn_sched_barrier(0);
#undef QK_STEP
#undef ROWMAX_RESCALE
#undef SM_STEP
#pragma unroll
            for (int ks = 0; ks < 4; ++ks) {
                const bf16x8 pb = __builtin_bit_cast(bf16x8, pwb[ks]);
                o[1][0] = __builtin_amdgcn_mfma_f32_32x32x16_bf16(vf[2 * ks], pb, o[1][0], 0, 0, 0);
                o[1][1] = __builtin_amdgcn_mfma_f32_32x32x16_bf16(vf[2 * ks + 1], pb, o[1][1], 0, 0, 0);
            }
            __builtin_amdgcn_sched_barrier(0);
        }
        if (t + 1 < NT) {
            unsigned char* nb = shm + ((t + 1) & 1) * BUFB;
            *reinterpret_cast<u32x4*>(nb + kst) = kreg; *reinterpret_cast<u32x4*>(nb + vst) = vreg;
            if (DQ == 96) { if (tid < 256) *reinterpret_cast<u32x4*>(nb + pst) = preg; }
        }
        __syncthreads();
    }
#pragma unroll
    for (int sb = 0; sb < 2; ++sb) {
        const float lt = xsum(l_run[sb]);
        const float inv = 1.0f / lt;
        bf16_t* op = (sb == 0 ? O0 : O1) + (size_t)(wid * 32 + r32) * DM + 4 * hi;
#pragma unroll
        for (int g = 0; g < 4; ++g) {
            *reinterpret_cast<u32x2*>(op + 8 * g) = (u32x2){cvtpk(o[sb][0][4 * g] * inv, o[sb][0][4 * g + 1] * inv), cvtpk(o[sb][0][4 * g + 2] * inv, o[sb][0][4 * g + 3] * inv)};
            *reinterpret_cast<u32x2*>(op + 32 + 8 * g) = (u32x2){cvtpk(o[sb][1][4 * g] * inv, o[sb][1][4 * g + 1] * inv), cvtpk(o[sb][1][4 * g + 2] * inv, o[sb][1][4 * g + 3] * inv)};
        }
    }
}

template <int MODE>
__device__ __forceinline__ void conv_weight(const float* __restrict__ W, int K, int N, bf16_t* __restrict__ dst, int ldb,
                                            const float* __restrict__ gA, const float* __restrict__ gB, int gtid, int gthreads) {
    const int total = N * (K / 8);
    for (int i = gtid; i < total; i += gthreads) {
        const int kq = i / N, n = i - kq * N, k0 = kq * 8;
        float v[8];
#pragma unroll
        for (int j = 0; j < 8; ++j) {
            float w = W[(size_t)(k0 + j) * N + n];
            if (MODE == 1) w *= gA[k0 + j];
            if (MODE == 2) w *= (k0 + j < 512) ? gA[k0 + j] : gB[k0 + j - 512];
            v[j] = w;
        }
        int row = n;
        if (MODE == 3) row = (n >> 7) * 256 + (n & 127);
        if (MODE == 4) row = (n >> 7) * 256 + 128 + (n & 127);
        *reinterpret_cast<u32x4*>(dst + (size_t)row * ldb + k0) = (u32x4){cvtpk(v[0], v[1]), cvtpk(v[2], v[3]), cvtpk(v[4], v[5]), cvtpk(v[6], v[7])};
    }
}

#define LAS __attribute__((address_space(3)))
#define XB_TMO      128
#define XB_XCNT(j)  (256  + 64 * (j))
#define XB_XSUB(j)  (1280 + 64 * (j))
#define XB_XGEN(j)  (2304 + 64 * (j))
#define XB_TOP      3328
#define XB_TOPGEN   3392
#define XCD_BAR_WORDS 3456
#define XB_SPIN_CAP (1u << 18)
__device__ __forceinline__ unsigned xb_ld(unsigned* p)              { return __hip_atomic_load(p, __ATOMIC_RELAXED, __HIP_MEMORY_SCOPE_AGENT); }
__device__ __forceinline__ unsigned xb_add(unsigned* p, unsigned v) { return __hip_atomic_fetch_add(p, v, __ATOMIC_RELAXED, __HIP_MEMORY_SCOPE_AGENT); }
__device__ __forceinline__ unsigned xb_xcc_id() { return (unsigned)__builtin_amdgcn_s_getreg((3 << 11) | 20) & 0xFu; }
#define XB_SPIN(cond, bar) do { unsigned _sp = 0; while (cond) { __builtin_amdgcn_s_sleep(1); \
    if ((++_sp & 255u) == 0u) { if (xb_ld(&(bar)[XB_TMO])) break; if (_sp > XB_SPIN_CAP) { atomicAdd(&(bar)[XB_TMO], 1u); break; } } } } while (0)
__device__ __forceinline__ void xcd_barrier_complete(unsigned* bar, unsigned x, unsigned& nloc, unsigned& nx) {
    const unsigned G = gridDim.x * gridDim.y * gridDim.z;
    unsigned sum, cnt, mine, sp = 0u;
    for (;;) {
        sum = 0u; cnt = 0u; mine = 0u;
#pragma unroll
        for (unsigned j = 0; j < 16; ++j) { const unsigned c = xb_ld(&bar[XB_XCNT(j)]); sum += c; cnt += (c > 0u) ? 1u : 0u; mine = (j == x) ? c : mine; }
        if (sum == G) break;
        __builtin_amdgcn_s_sleep(1);
        if ((++sp & 255u) == 0u) { if (xb_ld(&bar[XB_TMO])) break; if (sp > XB_SPIN_CAP) { atomicAdd(&bar[XB_TMO], 1u); break; } }
    }
    nloc = mine > 0u ? mine : 1u; nx = cnt > 0u ? cnt : 1u;
}
__device__ __forceinline__ void xcd_barrier(unsigned* bar, unsigned x, volatile LAS unsigned* st, bool leader) {
    asm volatile("s_waitcnt vmcnt(0)" ::: "memory");
    __syncthreads();
    if (leader) {
        __builtin_amdgcn_s_waitcnt(0);
        unsigned nloc = st[0], nx = st[1];
        if (nloc == 0u) { xcd_barrier_complete(bar, x, nloc, nx); st[0] = nloc; st[1] = nx; }
        const unsigned old = xb_add(&bar[XB_XSUB(x)], 1u);
        const unsigned gen = old / nloc;
        if (old + 1u == (gen + 1u) * nloc) {
            __builtin_amdgcn_fence(__ATOMIC_RELEASE, "agent");
            asm volatile("s_waitcnt vmcnt(0)" ::: "memory");
            const unsigned og = xb_add(&bar[XB_TOP], 1u);
            const unsigned tg = og / nx;
            if (og + 1u == (tg + 1u) * nx) xb_add(&bar[XB_TOPGEN], 1u);
            else XB_SPIN(xb_ld(&bar[XB_TOPGEN]) == tg, bar);
            __builtin_amdgcn_fence(__ATOMIC_ACQUIRE, "agent");
            xb_add(&bar[XB_XGEN(x)], 1u);
            asm volatile("s_waitcnt vmcnt(0)" ::: "memory");
        } else {
            XB_SPIN(xb_ld(&bar[XB_XGEN(x)]) == gen, bar);
            __builtin_amdgcn_fence(__ATOMIC_ACQUIRE, "agent");
            asm volatile("s_waitcnt vmcnt(0)" ::: "memory");
        }
    }
    __syncthreads();
}

__global__ void __launch_bounds__(512) fwd_kernel(Params p) {
    extern __shared__ __attribute__((aligned(16))) unsigned char lds[];
    cg::grid_group grid = cg::this_grid();
    const int tid = threadIdx.x, lane = tid & 63, wv = tid >> 6;
    const int G = gridDim.x, bx = blockIdx.x;
    const int vcu = ((G & 7) == 0) ? (bx % 8) * (G / 8) + bx / 8 : bx;
    unsigned char* ws = p.ws;
    const float* xp = p.in[0]; const float* xs = p.in[1];
    bf16_t* W1t = (bf16_t*)(ws + WS_W1T); bf16_t* Wuqt = (bf16_t*)(ws + WS_WUQT); bf16_t* Wukvt = (bf16_t*)(ws + WS_WUKVT);
    bf16_t* Woutt = (bf16_t*)(ws + WS_WOUTT); bf16_t* Wgut = (bf16_t*)(ws + WS_WGUT); bf16_t* Wdnt = (bf16_t*)(ws + WS_WDNT);
    float* mod = (float*)(ws + WS_MOD);
    float* cosA = (float*)(ws + WS_COSA); float* sinA = (float*)(ws + WS_SINA); float* cosB = (float*)(ws + WS_COSB); float* sinB = (float*)(ws + WS_SINB);
    float* rsq = (float*)(ws + WS_RSQ); float* rskv = (float*)(ws + WS_RSKV);
    bf16_t* U = (bf16_t*)(ws + WS_U); bf16_t* H = (bf16_t*)(ws + WS_H); bf16_t* Ob = (bf16_t*)(ws + WS_O);
    bf16_t* Qa = (bf16_t*)(ws + WS_QA); bf16_t* Ka = (bf16_t*)(ws + WS_KA); bf16_t* Vta = (bf16_t*)(ws + WS_VTA);
    bf16_t* Qm = (bf16_t*)(ws + WS_QM); bf16_t* Kn = (bf16_t*)(ws + WS_KN); bf16_t* Kpe = (bf16_t*)(ws + WS_KPE); bf16_t* Vtm = (bf16_t*)(ws + WS_VTM);
    bf16_t* F = (bf16_t*)(ws + WS_F);
    float* out = p.out;
    const int lo = p.lo, hi_ = p.hi;
#ifndef PH_MASK
#define PH_MASK 0xFFF
#endif
#define IN(k) (((PH_MASK >> (k)) & 1) && lo <= (k) && (k) < hi_)
#define SEAM(k) do { if (IN(k) && IN((k) + 1)) { if ((k) == 0) grid.sync(); else xcd_barrier(xbar, xcc, xst, tid == 0); } } while (0)
    unsigned* const xbar = (unsigned*)(p.ws + WS_BAR);
    volatile LAS unsigned* const xst = (volatile LAS unsigned*)((LAS unsigned char*)lds + LDS_XST);
    const unsigned xcc = xb_xcc_id();
    if (tid == 0) { xst[0] = 0u; xst[1] = 0u; (void)xb_add(&xbar[XB_XCNT(xcc)], 1u); }
    __syncthreads();

    if (IN(0)) {
        float* s_c = (float*)lds;
        float* red = (float*)(lds + 65536);
        const float* cpr = p.in[2]; const float* csm = p.in[3]; const float* w_ada = p.in[4]; const float* b_ada = p.in[5];
        for (int cb = bx; cb < 192; cb += G) {
            for (int i = tid; i < 16 * 1024; i += 512) {
                const int b = i >> 10, k = i & 1023; const float c = (b < 8) ? cpr[b * 1024 + k] : csm[(b - 8) * 1024 + k];
                s_c[i] = c / (1.0f + __expf(-c));
            }
            __syncthreads();
            const int kgp = tid >> 5, cl = tid & 31, col = cb * 32 + cl;
            float a[16];
#pragma unroll
            for (int b = 0; b < 16; ++b) a[b] = 0.f;
            for (int k = kgp * 64; k < kgp * 64 + 64; ++k) {
                const float w = w_ada[(size_t)k * 6144 + col];
#pragma unroll
                for (int b = 0; b < 16; ++b) a[b] += s_c[b * 1024 + k] * w;
            }
#pragma unroll
            for (int b = 0; b < 16; ++b) red[(kgp * 16 + b) * 32 + cl] = a[b];
            __syncthreads();
            { const int b = tid >> 5; float s = 0.f;
#pragma unroll
              for (int k2 = 0; k2 < 16; ++k2) s += red[(k2 * 16 + b) * 32 + cl];
              mod[b * 6144 + col] = s + b_ada[col]; }
            __syncthreads();
        }
        const int gtid = bx * 512 + tid, gth = G * 512;
        for (int i = gtid; i < 8192 * 48; i += gth) {
            const int s = i / 48, j = i - s * 48;
            int ii, n; if (j < 32) { ii = j; n = 16; } else { ii = j - 32; n = 8; }
            const int pos = (ii < n) ? (s >> 6) : (s & 63); const int fi = (ii < n) ? ii : ii - n;
            const float inv = exp2f(-((float)fi / (float)n) * 13.287712379549449f);
            const float ang = (float)pos * inv;
            const double rev = (double)ang * 0.15915494309189535; const float fr_ = (float)(rev - floor(rev));
            const float cv = __builtin_amdgcn_cosf(fr_), sv = __builtin_amdgcn_sinf(fr_);
            if (j < 32) { cosA[s * 32 + ii] = cv; sinA[s * 32 + ii] = sv; } else { cosB[s * 16 + ii] = cv; sinB[s * 16 + ii] = sv; }
        }
        conv_weight<0>(p.in[6], 1024, 1184, W1t, 1024, nullptr, nullptr, gtid, gth);
        for (int i = gtid; i < 96 * 1024 / 8; i += gth) *reinterpret_cast<u32x4*>(W1t + (size_t)1184 * 1024 + (size_t)i * 8) = (u32x4){0u, 0u, 0u, 0u};
        conv_weight<1>(p.in[10], 256, 768, Wuqt, 256, p.in[9], nullptr, gtid, gth);
        conv_weight<1>(p.in[12], 128, 1024, Wukvt, 256, p.in[11], nullptr, gtid, gth);
        for (int i = gtid; i < 1024 * 16; i += gth) { const int r = i >> 4, c = i & 15; *reinterpret_cast<u32x4*>(Wukvt + (size_t)r * 256 + 128 + c * 8) = (u32x4){0u, 0u, 0u, 0u}; }
        conv_weight<2>(p.in[15], 1024, 1024, Woutt, 1024, p.in[13], p.in[14], gtid, gth);
        conv_weight<3>(p.in[18], 1024, 2816, Wgut, 1024, nullptr, nullptr, gtid, gth);
        conv_weight<4>(p.in[19], 1024, 2816, Wgut, 1024, nullptr, nullptr, gtid, gth);
        conv_weight<0>(p.in[20], 2816, 1024, Wdnt, 2816, nullptr, nullptr, gtid, gth);
    }
    SEAM(0);

    if (IN(1)) {
        constexpr int NR = 4;
        for (int t0 = bx * 8 + wv; t0 < T; t0 += NR * G * 8) {
            f32x4 v[NR][4];
#pragma unroll
            for (int rr = 0; rr < NR; ++rr) {
                const int t = t0 + rr * G * 8; const float* xr = xrow(xp, xs, t < T ? t : t0);
#pragma unroll
                for (int c = 0; c < 4; ++c) v[rr][c] = *reinterpret_cast<const f32x4*>(xr + c * 256 + lane * 4);
            }
#pragma unroll
            for (int rr = 0; rr < NR; ++rr) {
                const int t = t0 + rr * G * 8;
                float s = 0.f;
#pragma unroll
                for (int c = 0; c < 4; ++c) s += (v[rr][c][0] + v[rr][c][1]) + (v[rr][c][2] + v[rr][c][3]);
                const float mean = wave_sum(s) * (1.0f / 1024.0f);
                float q = 0.f;
#pragma unroll
                for (int c = 0; c < 4; ++c) { v[rr][c] = v[rr][c] - mean; q += (v[rr][c][0] * v[rr][c][0] + v[rr][c][1] * v[rr][c][1]) + (v[rr][c][2] * v[rr][c][2] + v[rr][c][3] * v[rr][c][3]); }
                const float rstd = rsqrtf(wave_sum(q) * (1.0f / 1024.0f) + EPS);
                if (t < T) {
                    int b, S, tok0; tokinfo(t, b, S, tok0);
                    const float* md = mod + b * 6144;
#pragma unroll
                    for (int c = 0; c < 4; ++c) {
                        const int col = c * 256 + lane * 4;
                        const f32x4 sh = *reinterpret_cast<const f32x4*>(md + col), sc = *reinterpret_cast<const f32x4*>(md + 1024 + col);
                        const f32x4 y = v[rr][c] * rstd * (sc + 1.0f) + sh;
                        *reinterpret_cast<u32x2*>(U + (size_t)t * DM + col) = (u32x2){cvtpk(y[0], y[1]), cvtpk(y[2], y[3])};
                    }
                }
            }
        }
    }
    SEAM(1);

    if (IN(2)) {
        int pm, pn;
        for (int i = 0; tile_next(i, G, bx, NMT, 5, pm, pn); ++i) {
            f32x4 acc[2][2][4][2];
            const int brow = pm * 256, bcol = pn * 256;
            int b, S, tok0; tokinfo(brow, b, S, tok0);
            if (pn == 2) {
                gemm_core<false>(lds, U, DM, W1t, DM, 16, brow, bcol, acc);
                EPI_GEOM
#pragma unroll
                for (int ai = 0; ai < 2; ++ai)
#pragma unroll
                    for (int m = 0; m < 4; ++m) {
                        asm volatile("" ::: "memory"); const int row = brow + ai * 128 + wr * 64 + m * 16 + fq * 4;
#pragma unroll
                        for (int bj = 0; bj < 2; ++bj)
#pragma unroll
                            for (int n = 0; n < 2; ++n) {
                                const int col = bcol + bj * 128 + wc * 32 + n * 16 + fr; const f32x4 v = acc[ai][bj][m][n];
                                if (bj == 1) {
                                    const size_t off = (size_t)tok0 * 128 + (size_t)(col - 640) * S + (row - tok0);
                                    *reinterpret_cast<u32x2*>(Vta + off) = (u32x2){cvtpk(v[0], v[1]), cvtpk(v[2], v[3])};
                                } else {
#pragma unroll
                                    for (int j = 0; j < 4; ++j) H[(size_t)(row + j) * HP + col] = f2bf(v[j]);
                                }
                            }
                    }
            } else {
                gemm_core<true>(lds, U, DM, W1t, DM, 16, brow, bcol, acc);
                EPI_GEOM
#pragma unroll
                for (int ai = 0; ai < 2; ++ai)
#pragma unroll
                    for (int m = 0; m < 4; ++m) {
                        asm volatile("" ::: "memory"); const int row = brow + ai * 128 + wr * 64 + m * 16 + fr;
#pragma unroll
                        for (int bj = 0; bj < 2; ++bj)
#pragma unroll
                            for (int n = 0; n < 2; ++n) {
                                const int c0 = bcol + bj * 128 + wc * 32 + n * 16 + fq * 4; const f32x4 v = acc[ai][bj][m][n];
                                *reinterpret_cast<u32x2*>(H + (size_t)row * HP + c0) = (u32x2){cvtpk(v[0], v[1]), cvtpk(v[2], v[3])};
                            }
                    }
                if (pn >= 3) {
                    float* part = (float*)(ws + (pn == 3 ? WS_PQ : WS_PKV));
#pragma unroll
                    for (int ai = 0; ai < 2; ++ai)
#pragma unroll
                        for (int m = 0; m < 4; ++m) {
                            const int row = brow + ai * 128 + wr * 64 + m * 16 + fr;
                            float sq = 0.f;
#pragma unroll
                            for (int n = 0; n < 2; ++n) {
                                const f32x4 v0 = acc[ai][0][m][n], v1 = acc[ai][1][m][n];
                                sq += (v0[0] * v0[0] + v0[1] * v0[1]) + (v0[2] * v0[2] + v0[3] * v0[3]);
                                if (pn == 3) sq += (v1[0] * v1[0] + v1[1] * v1[1]) + (v1[2] * v1[2] + v1[3] * v1[3]);
                            }
                            sq += __shfl_xor(sq, 16); sq += __shfl_xor(sq, 32);
                            part[(size_t)row * 4 + wc] = sq;
                        }
                }
            }
        }
    }
    SEAM(2);

    if (IN(3)) {
        const float* gq = p.in[7]; const float* gk = p.in[8];
        for (int t = bx * 8 + wv; t < T; t += G * 8) {
            int b, S, tok0; tokinfo(t, b, S, tok0); const int s = t - tok0;
            const bf16_t* hr = H + (size_t)t * HP;
            if (lane < 40) {
                const int hh = lane >> 2, c = lane & 3; const bool isq = hh < 8;
                const u32x4 a1 = *reinterpret_cast<const u32x4*>(hr + hh * 64 + c * 8), a2 = *reinterpret_cast<const u32x4*>(hr + hh * 64 + 32 + c * 8);
                float x1[8], x2[8]; float ss = 0.f;
#pragma unroll
                for (int e = 0; e < 4; ++e) {
                    x1[2 * e] = __uint_as_float(a1[e] << 16); x1[2 * e + 1] = __uint_as_float(a1[e] & 0xffff0000u);
                    x2[2 * e] = __uint_as_float(a2[e] << 16); x2[2 * e + 1] = __uint_as_float(a2[e] & 0xffff0000u);
                }
#pragma unroll
                for (int e = 0; e < 8; ++e) ss += x1[e] * x1[e] + x2[e] * x2[e];
                ss += __shfl_xor(ss, 1); ss += __shfl_xor(ss, 2);
                const float rstd = rsqrtf(ss * (1.0f / 64.0f) + EPS);
                const float* g = isq ? gq : gk; const float scl = isq ? C2A : 1.0f;
                float o1[8], o2[8];
#pragma unroll
                for (int e = 0; e < 8; ++e) {
                    const int d1 = c * 8 + e;
                    const float a = x1[e] * rstd * g[d1], bb = x2[e] * rstd * g[d1 + 32];
                    const float cs = cosA[s * 32 + d1], sn = sinA[s * 32 + d1];
                    o1[e] = (a * cs - bb * sn) * scl; o2[e] = (a * sn + bb * cs) * scl;
                }
                bf16_t* dst = isq ? (Qa + (size_t)t * 512 + hh * 64 + c * 8) : (Ka + (size_t)t * 128 + (hh - 8) * 64 + c * 8);
                *reinterpret_cast<u32x4*>(dst) = (u32x4){cvtpk(o1[0], o1[1]), cvtpk(o1[2], o1[3]), cvtpk(o1[4], o1[5]), cvtpk(o1[6], o1[7])};
                *reinterpret_cast<u32x4*>(dst + 32) = (u32x4){cvtpk(o2[0], o2[1]), cvtpk(o2[2], o2[3]), cvtpk(o2[4], o2[5]), cvtpk(o2[6], o2[7])};
            }
            if (lane < 2) {
                const u32x4 a1 = *reinterpret_cast<const u32x4*>(hr + 1152 + lane * 8), a2 = *reinterpret_cast<const u32x4*>(hr + 1152 + 16 + lane * 8);
                float o1[8], o2[8];
#pragma unroll
                for (int e = 0; e < 4; ++e) {
#pragma unroll
                    for (int h2 = 0; h2 < 2; ++h2) {
                        const int ee = 2 * e + h2, i = lane * 8 + ee;
                        const float a = h2 ? __uint_as_float(a1[e] & 0xffff0000u) : __uint_as_float(a1[e] << 16);
                        const float bb = h2 ? __uint_as_float(a2[e] & 0xffff0000u) : __uint_as_float(a2[e] << 16);
                        const float cs = cosB[s * 16 + i], sn = sinB[s * 16 + i];
                        o1[ee] = a * cs - bb * sn; o2[ee] = a * sn + bb * cs;
                    }
                }
                bf16_t* dst = Kpe + (size_t)t * 32 + lane * 8;
                *reinterpret_cast<u32x4*>(dst) = (u32x4){cvtpk(o1[0], o1[1]), cvtpk(o1[2], o1[3]), cvtpk(o1[4], o1[5]), cvtpk(o1[6], o1[7])};
                *reinterpret_cast<u32x4*>(dst + 16) = (u32x4){cvtpk(o2[0], o2[1]), cvtpk(o2[2], o2[3]), cvtpk(o2[4], o2[5]), cvtpk(o2[6], o2[7])};
            }
        }
    }

    if (IN(4)) {
        int pm, pn;
        for (int i = 0; tile_next(i, G, bx, NMT, 7, pm, pn); ++i) {
            f32x4 acc[2][2][4][2];
            const int brow = pm * 256;
            const bool isq = pn < 3;
            const bf16_t* A = H + (isq ? 768 : 1024);
            const bf16_t* Bt = isq ? Wuqt : Wukvt;
            const int bcol = isq ? pn * 256 : (pn - 3) * 256;
            int b, S, tok0; tokinfo(brow, b, S, tok0);
            if (isq) {
                gemm_core<true>(lds, A, HP, Bt, 256, 4, brow, bcol, acc);
                EPI_GEOM
#pragma unroll
                for (int ai = 0; ai < 2; ++ai)
#pragma unroll
                    for (int m = 0; m < 4; ++m) {
                        asm volatile("" ::: "memory"); const int row = brow + ai * 128 + wr * 64 + m * 16 + fr;
                        const f32x4 pq = *reinterpret_cast<const f32x4*>((const float*)(ws + WS_PQ) + (size_t)row * 4);
                        const float rs = rsqrtf(((pq[0] + pq[1]) + (pq[2] + pq[3])) * (1.0f / 256.0f) + EPS) * C2M; const int sp = row - tok0;
                        const f32x4 cs = *reinterpret_cast<const f32x4*>(cosB + sp * 16 + fq * 4), sn = *reinterpret_cast<const f32x4*>(sinB + sp * 16 + fq * 4);
#pragma unroll
                        for (int bj = 0; bj < 2; ++bj) {
                            const int g32 = pn * 8 + bj * 4 + wc; const bool isrope = (g32 % 3) == 2; const int colb = g32 * 32 + fq * 4;
                            f32x4 v0 = acc[ai][bj][m][0] * rs, v1 = acc[ai][bj][m][1] * rs;
                            if (isrope) { const f32x4 ra = v0 * cs - v1 * sn, rb = v0 * sn + v1 * cs; v0 = ra; v1 = rb; }
                            *reinterpret_cast<u32x2*>(Qm + (size_t)row * 768 + colb) = (u32x2){cvtpk(v0[0], v0[1]), cvtpk(v0[2], v0[3])};
                            *reinterpret_cast<u32x2*>(Qm + (size_t)row * 768 + colb + 16) = (u32x2){cvtpk(v1[0], v1[1]), cvtpk(v1[2], v1[3])};
                        }
                    }
            } else {
                gemm_core<false>(lds, A, HP, Bt, 256, 4, brow, bcol, acc);
                EPI_GEOM
#pragma unroll
                for (int ai = 0; ai < 2; ++ai)
#pragma unroll
                    for (int m = 0; m < 4; ++m) {
                        asm volatile("" ::: "memory"); const int row = brow + ai * 128 + wr * 64 + m * 16 + fq * 4;
                        float rs[4];
#pragma unroll
                        for (int j = 0; j < 4; ++j) { const f32x4 pk = *reinterpret_cast<const f32x4*>((const float*)(ws + WS_PKV) + (size_t)(row + j) * 4); rs[j] = rsqrtf(((pk[0] + pk[1]) + (pk[2] + pk[3])) * (1.0f / 128.0f) + EPS); }
#pragma unroll
                        for (int bj = 0; bj < 2; ++bj) {
                            const int head = (pn - 3) * 2 + bj;
#pragma unroll
                            for (int n = 0; n < 2; ++n) {
                                const int within = wc * 32 + n * 16 + fr; const f32x4 v = acc[ai][bj][m][n];
                                if (wc < 2) {
#pragma unroll
                                    for (int j = 0; j < 4; ++j) Kn[(size_t)(row + j) * 512 + head * 64 + within] = f2bf(v[j] * rs[j]);
                                } else {
                                    const size_t off = (size_t)tok0 * 512 + (size_t)(head * 64 + within - 64) * S + (row - tok0);
                                    *reinterpret_cast<u32x2*>(Vtm + off) = (u32x2){cvtpk(v[0] * rs[0], v[1] * rs[1]), cvtpk(v[2] * rs[2], v[3] * rs[3])};
                                }
                            }
                        }
                    }
            }
        }
    }
    SEAM(4);

    if (IN(5)) {
#ifndef NO_MLA
        for (int u = vcu; u < 1280; u += G) {
            const bool smp = u < 1024; const int idx = smp ? u : u - 1024;
            const int S = smp ? 8192 : 2048;
            const int nqb = S / 512, qb = idx % nqb, head = (idx / nqb) & 7, bl = idx / (nqb * 8);
            const int tok0 = smp ? TP + bl * 8192 : bl * 2048, q0 = tok0 + qb * 512;
            const bf16_t* q = Qm + (size_t)q0 * 768 + head * 96; bf16_t* o = Ob + (size_t)q0 * DM + 512 + head * 64;
            attn_unit2<96>(lds, q, q + (size_t)256 * 768, 768, Kn + (size_t)tok0 * 512 + head * 64, 512, Kpe + (size_t)tok0 * 32,
                           Vtm + (size_t)tok0 * 512 + (size_t)head * 64 * S, S, o, o + (size_t)256 * DM);
        }
#endif
#ifndef NO_GQA
        for (int u = vcu; u < 1280; u += G) {
            const bool smp = u < 1024; const int idx = smp ? u : u - 1024;
            const int S = smp ? 8192 : 2048;
            const int nqb = S / 256, qb = idx % nqb, hp = (idx / nqb) & 3, bl = idx / (nqb * 4);
            const int kvh = hp >> 1, head = hp * 2;
            const int tok0 = smp ? TP + bl * 8192 : bl * 2048, q0 = tok0 + qb * 256;
            const bf16_t* q = Qa + (size_t)q0 * 512 + head * 64; bf16_t* o = Ob + (size_t)q0 * DM + head * 64;
            attn_unit2<64>(lds, q, q + 64, 512, Ka + (size_t)tok0 * 128 + kvh * 64, 128, nullptr,
                           Vta + (size_t)tok0 * 128 + (size_t)kvh * 64 * S, S, o, o + 64);
        }
#endif
    }
    SEAM(5);

    if (IN(6)) {
        constexpr int NR = 4;
        for (int t0 = bx * 8 + wv; t0 < T; t0 += NR * G * 8) {
            u32x4 ra[NR], rc[NR];
#pragma unroll
            for (int rr = 0; rr < NR; ++rr) {
                const int t = t0 + rr * G * 8; const bf16_t* orow = Ob + (size_t)(t < T ? t : t0) * DM + lane * 16;
                ra[rr] = *reinterpret_cast<const u32x4*>(orow); rc[rr] = *reinterpret_cast<const u32x4*>(orow + 8);
            }
#pragma unroll
            for (int rr = 0; rr < NR; ++rr) {
                const int t = t0 + rr * G * 8;
                float x[16];
#pragma unroll
                for (int e = 0; e < 4; ++e) { x[2 * e] = __uint_as_float(ra[rr][e] << 16); x[2 * e + 1] = __uint_as_float(ra[rr][e] & 0xffff0000u); x[8 + 2 * e] = __uint_as_float(rc[rr][e] << 16); x[8 + 2 * e + 1] = __uint_as_float(rc[rr][e] & 0xffff0000u); }
                float ss = 0.f;
#pragma unroll
                for (int e = 0; e < 16; ++e) ss += x[e] * x[e];
#pragma unroll
                for (int o = 16; o >= 1; o >>= 1) ss += __shfl_xor(ss, o);
                const float rstd = rsqrtf(ss * (1.0f / 512.0f) + EPS);
#pragma unroll
                for (int e = 0; e < 16; ++e) x[e] *= rstd;
                if (t < T) {
                    bf16_t* orow = Ob + (size_t)t * DM + lane * 16;
                    *reinterpret_cast<u32x4*>(orow) = (u32x4){cvtpk(x[0], x[1]), cvtpk(x[2], x[3]), cvtpk(x[4], x[5]), cvtpk(x[6], x[7])};
                    *reinterpret_cast<u32x4*>(orow + 8) = (u32x4){cvtpk(x[8], x[9]), cvtpk(x[10], x[11]), cvtpk(x[12], x[13]), cvtpk(x[14], x[15])};
                }
            }
        }
    }
    SEAM(6);

    if (IN(7)) {
        int pm, pn;
        for (int i = 0; tile_next(i, G, bx, NMT, 4, pm, pn); ++i) {
            f32x4 acc[2][2][4][2];
            const int brow = pm * 256, bcol = pn * 256;
            gemm_core<true>(lds, Ob, DM, Woutt, DM, 16, brow, bcol, acc);
            EPI_GEOM
            int b, S, tok0; tokinfo(brow, b, S, tok0);
            const float* g1 = mod + b * 6144 + 2048;
            const int cl = wc * 32 + fq * 4;
            f32x4 gv[2][2], xv[2][2][2];
#pragma unroll
            for (int bj = 0; bj < 2; ++bj)
#pragma unroll
                for (int n = 0; n < 2; ++n) gv[bj][n] = *reinterpret_cast<const f32x4*>(g1 + bcol + bj * 128 + n * 16 + cl);
            { const float* xr = xrow(xp, xs, brow + wr * 64 + fr);
#pragma unroll
              for (int bj = 0; bj < 2; ++bj)
#pragma unroll
                  for (int n = 0; n < 2; ++n) xv[0][bj][n] = *reinterpret_cast<const f32x4*>(xr + bcol + bj * 128 + n * 16 + cl); }
#pragma unroll
            for (int it = 0; it < 8; ++it) {
                const int ai = it >> 2, m = it & 3;
                if (it + 1 < 8) {
                    const float* xr = xrow(xp, xs, brow + ((it + 1) >> 2) * 128 + wr * 64 + ((it + 1) & 3) * 16 + fr);
#pragma unroll
                    for (int bj = 0; bj < 2; ++bj)
#pragma unroll
                        for (int n = 0; n < 2; ++n) xv[(it + 1) & 1][bj][n] = *reinterpret_cast<const f32x4*>(xr + bcol + bj * 128 + n * 16 + cl);
                }
                const int row = brow + ai * 128 + wr * 64 + m * 16 + fr;
#pragma unroll
                for (int bj = 0; bj < 2; ++bj)
#pragma unroll
                    for (int n = 0; n < 2; ++n)
                        *reinterpret_cast<f32x4*>(out + (size_t)row * DM + bcol + bj * 128 + n * 16 + cl) = xv[it & 1][bj][n] * ALPHA + gv[bj][n] * acc[ai][bj][m][n];
                asm volatile("" ::: "memory");
            }
        }
    }
    SEAM(7);

    if (IN(8)) {
        const float* l1g = p.in[16]; const float* l1b = p.in[17];
        constexpr int NR = 4;
        for (int t0 = bx * 8 + wv; t0 < T; t0 += NR * G * 8) {
            f32x4 v[NR][4];
#pragma unroll
            for (int rr = 0; rr < NR; ++rr) {
                const int t = t0 + rr * G * 8; const float* orow = out + (size_t)(t < T ? t : t0) * DM;
#pragma unroll
                for (int c = 0; c < 4; ++c) v[rr][c] = *reinterpret_cast<const f32x4*>(orow + c * 256 + lane * 4);
            }
#pragma unroll
            for (int rr = 0; rr < NR; ++rr) {
                const int t = t0 + rr * G * 8;
                float* orow = out + (size_t)t * DM;
                float s = 0.f;
#pragma unroll
                for (int c = 0; c < 4; ++c) s += (v[rr][c][0] + v[rr][c][1]) + (v[rr][c][2] + v[rr][c][3]);
                float mean = wave_sum(s) * (1.0f / 1024.0f);
                float q = 0.f;
#pragma unroll
                for (int c = 0; c < 4; ++c) { v[rr][c] = v[rr][c] - mean; q += (v[rr][c][0] * v[rr][c][0] + v[rr][c][1] * v[rr][c][1]) + (v[rr][c][2] * v[rr][c][2] + v[rr][c][3] * v[rr][c][3]); }
                float rstd = rsqrtf(wave_sum(q) * (1.0f / 1024.0f) + EPS);
                s = 0.f;
#pragma unroll
                for (int c = 0; c < 4; ++c) {
                    const int col = c * 256 + lane * 4;
                    v[rr][c] = v[rr][c] * rstd * *reinterpret_cast<const f32x4*>(l1g + col) + *reinterpret_cast<const f32x4*>(l1b + col);
                    if (t < T) *reinterpret_cast<f32x4*>(orow + col) = v[rr][c];
                    s += (v[rr][c][0] + v[rr][c][1]) + (v[rr][c][2] + v[rr][c][3]);
                }
                mean = wave_sum(s) * (1.0f / 1024.0f);
                q = 0.f;
#pragma unroll
                for (int c = 0; c < 4; ++c) { v[rr][c] = v[rr][c] - mean; q += (v[rr][c][0] * v[rr][c][0] + v[rr][c][1] * v[rr][c][1]) + (v[rr][c][2] * v[rr][c][2] + v[rr][c][3] * v[rr][c][3]); }
                rstd = rsqrtf(wave_sum(q) * (1.0f / 1024.0f) + EPS);
                if (t < T) {
                    int b, S, tok0; tokinfo(t, b, S, tok0);
                    const float* md = mod + b * 6144;
#pragma unroll
                    for (int c = 0; c < 4; ++c) {
                        const int col = c * 256 + lane * 4;
                        const f32x4 sh = *reinterpret_cast<const f32x4*>(md + 3072 + col), sc = *reinterpret_cast<const f32x4*>(md + 4096 + col);
                        const f32x4 y = v[rr][c] * rstd * (sc + 1.0f) + sh;
                        *reinterpret_cast<u32x2*>(U + (size_t)t * DM + col) = (u32x2){cvtpk(y[0], y[1]), cvtpk(y[2], y[3])};
                    }
                }
            }
        }
    }
    SEAM(8);

    if (IN(9)) {
        int pm, pn;
        for (int i = 0; tile_next(i, G, bx, NMT, 22, pm, pn); ++i) {
            f32x4 acc[2][2][4][2];
            const int brow = pm * 256, bcol = pn * 256;
            gemm_core<true>(lds, U, DM, Wgut, DM, 16, brow, bcol, acc);
            EPI_GEOM
#pragma unroll
            for (int ai = 0; ai < 2; ++ai)
#pragma unroll
                for (int m = 0; m < 4; ++m) {
                    asm volatile("" ::: "memory"); const int row = brow + ai * 128 + wr * 64 + m * 16 + fr;
#pragma unroll
                    for (int n = 0; n < 2; ++n) {
                        const int c0 = pn * 128 + wc * 32 + n * 16 + fq * 4; const f32x4 g = acc[ai][0][m][n], uu = acc[ai][1][m][n];
                        float f[4];
#pragma unroll
                        for (int j = 0; j < 4; ++j) {
                            const float e = __builtin_amdgcn_exp2f(-LOG2E * g[j]);
                            f[j] = g[j] * __builtin_amdgcn_rcpf(1.0f + e) * uu[j];
                        }
                        *reinterpret_cast<u32x2*>(F + (size_t)row * DFF + c0) = (u32x2){cvtpk(f[0], f[1]), cvtpk(f[2], f[3])};
                    }
                }
        }
    }
    SEAM(9);

    if (IN(10)) {
        int pm, pn;
        for (int i = 0; tile_next(i, G, bx, NMT, 4, pm, pn); ++i) {
            f32x4 acc[2][2][4][2];
            const int brow = pm * 256, bcol = pn * 256;
            gemm_core<true>(lds, F, DFF, Wdnt, DFF, 44, brow, bcol, acc);
            EPI_GEOM
            int b, S, tok0; tokinfo(brow, b, S, tok0);
            const float* g2 = mod + b * 6144 + 5120;
            const int cl = wc * 32 + fq * 4;
            f32x4 gv[2][2], xv[2][2][2];
#pragma unroll
            for (int bj = 0; bj < 2; ++bj)
#pragma unroll
                for (int n = 0; n < 2; ++n) gv[bj][n] = *reinterpret_cast<const f32x4*>(g2 + bcol + bj * 128 + n * 16 + cl);
            { const float* xr = out + (size_t)(brow + wr * 64 + fr) * DM;
#pragma unroll
              for (int bj = 0; bj < 2; ++bj)
#pragma unroll
                  for (int n = 0; n < 2; ++n) xv[0][bj][n] = *reinterpret_cast<const f32x4*>(xr + bcol + bj * 128 + n * 16 + cl); }
#pragma unroll
            for (int it = 0; it < 8; ++it) {
                const int ai = it >> 2, m = it & 3;
                if (it + 1 < 8) {
                    const float* xr = out + (size_t)(brow + ((it + 1) >> 2) * 128 + wr * 64 + ((it + 1) & 3) * 16 + fr) * DM;
#pragma unroll
                    for (int bj = 0; bj < 2; ++bj)
#pragma unroll
                        for (int n = 0; n < 2; ++n) xv[(it + 1) & 1][bj][n] = *reinterpret_cast<const f32x4*>(xr + bcol + bj * 128 + n * 16 + cl);
                }
                const int row = brow + ai * 128 + wr * 64 + m * 16 + fr;
#pragma unroll
                for (int bj = 0; bj < 2; ++bj)
#pragma unroll
                    for (int n = 0; n < 2; ++n)
                        *reinterpret_cast<f32x4*>(out + (size_t)row * DM + bcol + bj * 128 + n * 16 + cl) = xv[it & 1][bj][n] * ALPHA + gv[bj][n] * acc[ai][bj][m][n];
                asm volatile("" ::: "memory");
            }
        }
    }
    SEAM(10);

    if (IN(11)) {
        const float* l2g = p.in[21]; const float* l2b = p.in[22];
        constexpr int NR = 4;
        for (int t0 = bx * 8 + wv; t0 < T; t0 += NR * G * 8) {
            f32x4 v[NR][4];
#pragma unroll
            for (int rr = 0; rr < NR; ++rr) {
                const int t = t0 + rr * G * 8; const float* orow = out + (size_t)(t < T ? t : t0) * DM;
#pragma unroll
                for (int c = 0; c < 4; ++c) v[rr][c] = *reinterpret_cast<const f32x4*>(orow + c * 256 + lane * 4);
            }
#pragma unroll
            for (int rr = 0; rr < NR; ++rr) {
                const int t = t0 + rr * G * 8;
                float* orow = out + (size_t)t * DM;
                float s = 0.f;
#pragma unroll
                for (int c = 0; c < 4; ++c) s += (v[rr][c][0] + v[rr][c][1]) + (v[rr][c][2] + v[rr][c][3]);
                const float mean = wave_sum(s) * (1.0f / 1024.0f);
                float q = 0.f;
#pragma unroll
                for (int c = 0; c < 4; ++c) { v[rr][c] = v[rr][c] - mean; q += (v[rr][c][0] * v[rr][c][0] + v[rr][c][1] * v[rr][c][1]) + (v[rr][c][2] * v[rr][c][2] + v[rr][c][3] * v[rr][c][3]); }
                const float rstd = rsqrtf(wave_sum(q) * (1.0f / 1024.0f) + EPS);
                if (t < T) {
#pragma unroll
                    for (int c = 0; c < 4; ++c) {
                        const int col = c * 256 + lane * 4;
                        *reinterpret_cast<f32x4*>(orow + col) = v[rr][c] * rstd * *reinterpret_cast<const f32x4*>(l2g + col) + *reinterpret_cast<const f32x4*>(l2b + col);
                    }
                }
            }
        }
    }
#undef IN
#undef SEAM
}

extern "C" void kernel_launch(void* const* d_in, const int* in_sizes, int n_in, void* d_out, int out_size, void* d_ws, size_t ws_size, hipStream_t stream) {
    static int grid_blocks = 0;
    if (grid_blocks == 0) {
        if (n_in != 23 || out_size != T * DM || ws_size < WS_END) { fprintf(stderr, "kernel_launch: unexpected shapes (n_in %d out %d ws %zu)\n", n_in, out_size, ws_size); grid_blocks = -1; return; }
        int dev = 0, cus = 0, per_cu = 0;
        hipGetDevice(&dev);
        hipDeviceGetAttribute(&cus, hipDeviceAttributeMultiprocessorCount, dev);
        if (hipFuncSetAttribute((const void*)fwd_kernel, hipFuncAttributeMaxDynamicSharedMemorySize, LDS_BYTES) != hipSuccess) { fprintf(stderr, "kernel_launch: hipFuncSetAttribute failed\n"); grid_blocks = -1; return; }
        if (hipOccupancyMaxActiveBlocksPerMultiprocessor(&per_cu, (const void*)fwd_kernel, 512, LDS_BYTES) != hipSuccess || per_cu < 1) { fprintf(stderr, "kernel_launch: occupancy query says %d\n", per_cu); per_cu = 1; }
        (void)hipGetLastError();
        grid_blocks = cus;
    }
    if (grid_blocks < 0) return;
    if (hipMemsetAsync((char*)d_ws + WS_BAR, 0, XCD_BAR_WORDS * 4, stream) != hipSuccess) { fprintf(stderr, "kernel_launch: hipMemsetAsync failed\n"); return; }
    Params p{};
    for (int i = 0; i < 23; ++i) p.in[i] = (const float*)d_in[i];
    p.out = (float*)d_out; p.ws = (unsigned char*)d_ws; p.lo = 0; p.hi = NPHASE;
    void* args[] = {&p};
    hipError_t e = hipLaunchCooperativeKernel((const void*)fwd_kernel, dim3(grid_blocks), dim3(512), args, LDS_BYTES, stream);
    if (e != hipSuccess) fprintf(stderr, "kernel_launch: cooperative launch failed: %s (grid %d)\n", hipGetErrorString(e), grid_blocks);
}
```

```cpp
#include <hip/hip_runtime.h>
#include <hip/hip_cooperative_groups.h>
#include <cstdio>
#include <cstdint>
namespace cg = cooperative_groups;

typedef unsigned short bf16_t;
typedef short bf16x8 __attribute__((ext_vector_type(8)));
typedef float f32x4 __attribute__((ext_vector_type(4)));
typedef float f32x16 __attribute__((ext_vector_type(16)));
typedef unsigned u32x4 __attribute__((ext_vector_type(4)));
typedef unsigned u32x2 __attribute__((ext_vector_type(2)));
typedef float f32x2_t __attribute__((ext_vector_type(2)));
typedef __bf16 bf16x2_t __attribute__((ext_vector_type(2)));

constexpr int DM = 1024, TP = 8 * 2048, TSMP = 8 * 8192, T = TP + TSMP;
constexpr int HP = 1280;
constexpr int DFF = 2816;
constexpr int NMT = T / 256;
constexpr float EPS = 1e-6f;
constexpr float ALPHA = 1.189207115002721f;
constexpr float LOG2E = 1.4426950408889634f;
constexpr float C2A = 0.125f * LOG2E;
constexpr float C2M = 0.10206207261596575f * LOG2E;

constexpr size_t MiB = 1u << 20;
constexpr size_t WS_W1T = 0;
constexpr size_t WS_WUQT = 3 * MiB;
constexpr size_t WS_WUKVT = 4 * MiB;
constexpr size_t WS_WOUTT = 5 * MiB;
constexpr size_t WS_WGUT = 7 * MiB;
constexpr size_t WS_WDNT = 18 * MiB;
constexpr size_t WS_MOD = 24 * MiB;
constexpr size_t WS_COSA = 25 * MiB;
constexpr size_t WS_SINA = 26 * MiB;
constexpr size_t WS_COSB = 27 * MiB;
constexpr size_t WS_SINB = 28 * MiB;
constexpr size_t WS_RSQ = 29 * MiB;
constexpr size_t WS_RSKV = 30 * MiB;
constexpr size_t WS_BAR = 31 * MiB;
constexpr size_t WS_U = 32 * MiB;
constexpr size_t WS_H = 192 * MiB;
constexpr size_t WS_O = 192 * MiB;
constexpr size_t WS_QA = 392 * MiB;
constexpr size_t WS_KA = 472 * MiB;
constexpr size_t WS_VTA = 492 * MiB;
constexpr size_t WS_QM = 512 * MiB;
constexpr size_t WS_KN = 632 * MiB;
constexpr size_t WS_KPE = 712 * MiB;
constexpr size_t WS_VTM = 717 * MiB;
constexpr size_t WS_F = 192 * MiB;
constexpr size_t WS_PQ = 800 * MiB;
constexpr size_t WS_PKV = 802 * MiB;
constexpr size_t WS_END = 804 * MiB;

constexpr int LDS_XST = 147456;
constexpr int LDS_BYTES = LDS_XST + 256;
constexpr int NPHASE = 12;

struct Params {
    const float* in[23];
    float* out;
    unsigned char* ws;
    int lo, hi;
};

__device__ __forceinline__ unsigned cvtpk(float lo, float hi) { f32x2_t v = {lo, hi}; bf16x2_t b = __builtin_convertvector(v, bf16x2_t); return __builtin_bit_cast(unsigned, b); }
__device__ __forceinline__ bf16_t f2bf(float f) { return (bf16_t)(cvtpk(f, 0.f) & 0xffffu); }
__device__ __forceinline__ float bf2f(unsigned short h) { return __uint_as_float(((unsigned)h) << 16); }
__device__ __forceinline__ float wave_sum(float v) {
#pragma unroll
    for (int o = 32; o >= 1; o >>= 1) v += __shfl_xor(v, o);
    return v;
}
__device__ __forceinline__ void tokinfo(int t, int& b, int& S, int& tok0) {
    if (t < TP) { b = t >> 11; S = 2048; tok0 = b << 11; }
    else { const int u = t - TP; const int bb = u >> 13; b = 8 + bb; S = 8192; tok0 = TP + (bb << 13); }
}
__device__ __forceinline__ const float* xrow(const float* xp, const float* xs, int t) {
    return t < TP ? xp + (size_t)t * DM : xs + (size_t)(t - TP) * DM;
}

constexpr int HTB = 128 * 64 * 2;
__device__ __forceinline__ int lds_byte(int r, int c) {
    const int st = (r >> 4) * 2 + (c >> 5), rr = r & 15, cc = c & 31, ob = rr * 64 + cc * 2;
    return st * 1024 + (ob ^ (((ob >> 9) & 1) << 5));
}
__device__ __forceinline__ void stage_rc(int b, int& R, int& C) {
    const int st = b / 1024, sb = b % 1024, swz = sb ^ (((sb >> 9) & 1) << 5);
    R = (st >> 1) * 16 + swz / 64; C = (st & 1) * 32 + (swz % 64) / 2;
}
__device__ __forceinline__ bool tile_next(int i, int G, int c, int nM, int nN, int& pm, int& pn) {
    const int nwg = nM * nN; const long L = (long)i * G + c; if (L >= nwg) return false;
    int wgid = (int)L;
    if ((G & 7) == 0) { const int q = nwg / 8, r = nwg % 8, xcd = wgid % 8, off = wgid / 8; wgid = (xcd < r ? xcd * (q + 1) : r * (q + 1) + (xcd - r) * q) + off; }
    const int nig = 8 * nN, gid = wgid / nig, fm = gid * 8, gsz = (nM - fm) < 8 ? (nM - fm) : 8;
    pm = fm + ((wgid % nig) % gsz); pn = (wgid % nig) / gsz; return true;
}

#define WAIT_V(n) asm volatile("s_waitcnt vmcnt(" #n ")" ::: "memory")
#define WAIT_L(n) asm volatile("s_waitcnt lgkmcnt(" #n ")" ::: "memory")
#define BAR __builtin_amdgcn_s_barrier()
#define SCHED __builtin_amdgcn_sched_barrier(0)

__device__ __forceinline__ void glds16(const void* sbase, unsigned voff, unsigned ldsdst) {
    unsigned keep;
    asm volatile("s_mov_b32 %0, m0\n\ts_mov_b32 m0, %3\n\ts_nop 0\n\tglobal_load_lds_dwordx4 %2, %1\n\ts_mov_b32 m0, %0"
                 : "=&s"(keep) : "s"(sbase), "v"(voff), "s"(ldsdst) : "memory");
}
template <bool TR>
__device__ __forceinline__ void gemm_core(unsigned char* shm, const bf16_t* __restrict__ A, int lda, const bf16_t* __restrict__ Bt, int ldb,
                                          int nt, int brow, int bcol, f32x4 (&acc)[2][2][4][2]) {
    const int wid = threadIdx.x >> 6, lane = threadIdx.x & 63, wr = wid >> 2, wc = wid & 3, fr = lane & 15, fq = lane >> 4;
    int sr0, sc0; stage_rc(threadIdx.x * 16, sr0, sc0);
    const unsigned offA = (unsigned)(sr0 * lda + sc0) * 2u, offB = (unsigned)(sr0 * ldb + sc0) * 2u;
    const unsigned ldsw = (unsigned)(uintptr_t)shm + (unsigned)__builtin_amdgcn_readfirstlane(wid) * 1024u;
#define SA(b, h) (shm + ((b) * 2 + (h)) * HTB)
#define SB(b, h) (shm + (4 + (b) * 2 + (h)) * HTB)
#define SAO(b, h) (((b) * 2 + (h)) * HTB)
#define SBO(b, h) ((4 + (b) * 2 + (h)) * HTB)
#define STAGE(PO, BASE, LD, VO, br, kt) do { \
        const char* b0_ = (const char*)(BASE) + ((long)(br) * (LD) + (long)(kt) * 64) * 2; \
        glds16(b0_, VO, ldsw + (PO)); glds16(b0_ + (long)(LD) * 128, VO, ldsw + (PO) + 8192u); } while (0)
#define LDA(dst, b, h) for (int m = 0; m < 4; ++m) for (int k = 0; k < 2; ++k) \
        dst[m][k] = *reinterpret_cast<const bf16x8*>(SA(b, h) + lds_byte(wr * 64 + m * 16 + fr, k * 32 + fq * 8))
#define LDB(dst, b, h) for (int n = 0; n < 2; ++n) for (int k = 0; k < 2; ++k) \
        dst[n][k] = *reinterpret_cast<const bf16x8*>(SB(b, h) + lds_byte(wc * 32 + n * 16 + fr, k * 32 + fq * 8))
#define MMA(ai, bj, At_, Bt_) do { __builtin_amdgcn_s_setprio(1); \
        for (int m = 0; m < 4; ++m) for (int n = 0; n < 2; ++n) for (int k = 0; k < 2; ++k) \
            acc[ai][bj][m][n] = TR ? __builtin_amdgcn_mfma_f32_16x16x32_bf16(Bt_[n][k], At_[m][k], acc[ai][bj][m][n], 0, 0, 0) \
                                   : __builtin_amdgcn_mfma_f32_16x16x32_bf16(At_[m][k], Bt_[n][k], acc[ai][bj][m][n], 0, 0, 0); \
        __builtin_amdgcn_s_setprio(0); } while (0)
    bf16x8 At[4][2], B0[2][2], B1[2][2];
#pragma unroll
    for (int a = 0; a < 2; ++a)
#pragma unroll
        for (int b = 0; b < 2; ++b)
#pragma unroll
            for (int m = 0; m < 4; ++m)
#pragma unroll
                for (int n = 0; n < 2; ++n) acc[a][b][m][n] = (f32x4){0.f, 0.f, 0.f, 0.f};
    STAGE(SBO(0, 0), Bt, ldb, offB, bcol, 0); STAGE(SAO(0, 0), A, lda, offA, brow, 0);
    STAGE(SBO(0, 1), Bt, ldb, offB, bcol + 128, 0); STAGE(SAO(0, 1), A, lda, offA, brow + 128, 0);
    if (wr == 1) BAR;
    WAIT_V(4); BAR;
    STAGE(SBO(1, 0), Bt, ldb, offB, bcol, 1); STAGE(SAO(1, 0), A, lda, offA, brow, 1); STAGE(SBO(1, 1), Bt, ldb, offB, bcol + 128, 1);
    WAIT_V(6); BAR;
    for (int t = 0; t < nt - 2; t += 2) {
        LDB(B0, 0, 0); SCHED; LDA(At, 0, 0); STAGE(SAO(1, 1), A, lda, offA, brow + 128, t + 1);
        WAIT_L(8); BAR; WAIT_L(0); MMA(0, 0, At, B0); BAR; SCHED;
        LDB(B1, 0, 1); STAGE(SBO(0, 0), Bt, ldb, offB, bcol, t + 2);
        BAR; WAIT_L(0); MMA(0, 1, At, B1); BAR;
        LDA(At, 0, 1); STAGE(SAO(0, 0), A, lda, offA, brow, t + 2);
        BAR; WAIT_L(0); MMA(1, 0, At, B0); BAR; SCHED;
        STAGE(SBO(0, 1), Bt, ldb, offB, bcol + 128, t + 2);
        WAIT_V(6); BAR; MMA(1, 1, At, B1); BAR;
        LDB(B0, 1, 0); SCHED; LDA(At, 1, 0); STAGE(SAO(0, 1), A, lda, offA, brow + 128, t + 2);
        WAIT_L(8); BAR; WAIT_L(0); MMA(0, 0, At, B0); BAR; SCHED;
        LDB(B1, 1, 1); STAGE(SBO(1, 0), Bt, ldb, offB, bcol, t + 3);
        BAR; WAIT_L(0); MMA(0, 1, At, B1); BAR;
        LDA(At, 1, 1); STAGE(SAO(1, 0), A, lda, offA, brow, t + 3);
        BAR; WAIT_L(0); MMA(1, 0, At, B0); BAR; SCHED;
        STAGE(SBO(1, 1), Bt, ldb, offB, bcol + 128, t + 3);
        WAIT_V(6); BAR; MMA(1, 1, At, B1); BAR;
    }
    { LDB(B0, 0, 0); LDA(At, 0, 0); STAGE(SAO(1, 1), A, lda, offA, brow + 128, nt - 1);
      BAR; WAIT_L(0); MMA(0, 0, At, B0); BAR;
      LDB(B1, 0, 1); BAR; WAIT_L(0); MMA(0, 1, At, B1); BAR;
      LDA(At, 0, 1); WAIT_V(4); BAR; WAIT_L(0); MMA(1, 0, At, B0); MMA(1, 1, At, B1); BAR; }
    { LDB(B0, 1, 0); LDA(At, 1, 0); WAIT_V(2); BAR; WAIT_L(0); MMA(0, 0, At, B0); BAR;
      LDB(B1, 1, 1); WAIT_V(0); BAR; WAIT_L(0); MMA(0, 1, At, B1); BAR;
      LDA(At, 1, 1); BAR; WAIT_L(0); MMA(1, 0, At, B0); MMA(1, 1, At, B1); BAR; }
    if (wr == 0) BAR;
#undef SA
#undef SB
#undef SAO
#undef SBO
#undef STAGE
#undef LDA
#undef LDB
#undef MMA
}

#define EPI_GEOM int tid_e = threadIdx.x; asm volatile("" : "+v"(tid_e)); const int wid = tid_e >> 6, lane = tid_e & 63, wr = wid >> 2, wc = wid & 3, fr = lane & 15, fq = lane >> 4; (void)wr; (void)wc; (void)fr; (void)fq;

__device__ __forceinline__ float dot2ones(unsigned pk, float acc) {
    return __builtin_amdgcn_fdot2_f32_bf16(__builtin_bit_cast(bf16x2_t, pk), __builtin_bit_cast(bf16x2_t, 0x3F803F80u), acc, false);
}
__device__ __forceinline__ int kperm(int i) { return (i & ~12) | ((i & 4) << 1) | ((i & 8) >> 1); }

__device__ __forceinline__ float xmax(float v) {
    auto rr = __builtin_amdgcn_permlane32_swap(__float_as_uint(v), __float_as_uint(v), false, false);
    return fmaxf(__uint_as_float(rr[0]), __uint_as_float(rr[1]));
}
__device__ __forceinline__ float xsum(float v) {
    auto rr = __builtin_amdgcn_permlane32_swap(__float_as_uint(v), __float_as_uint(v), false, false);
    return __uint_as_float(rr[0]) + __uint_as_float(rr[1]);
}
template <int DQ>
__device__ __forceinline__ void attn_unit2(unsigned char* shm, const bf16_t* __restrict__ Q0, const bf16_t* __restrict__ Q1, int ldq,
                                           const bf16_t* __restrict__ K1, int ldk1, const bf16_t* __restrict__ K2, const bf16_t* __restrict__ Vt, int S,
                                           bf16_t* __restrict__ O0, bf16_t* __restrict__ O1) {
    constexpr int KP = DQ * 2 + 16, VP = 144, VOFF = 64 * KP, BUFB = VOFF + 64 * VP, ND0 = DQ / 16;
    constexpr float THR = 6.0f;
    const int tid = threadIdx.x, lane = tid & 63, wid = tid >> 6, r32 = lane & 31, hi = lane >> 5;
    const int skey = tid >> 3, sch = tid & 7;
    const int pkey = tid >> 2, pch = tid & 3;
    const bf16_t* kg = K1 + (size_t)skey * ldk1 + sch * 8;
    const bf16_t* pg = (DQ == 96) ? (K2 + (size_t)pkey * 32 + pch * 8) : nullptr;
    const bf16_t* vg = Vt + (size_t)skey * S + sch * 8;
    const int kst = skey * KP + sch * 16, pst = pkey * KP + 128 + pch * 16, vst = VOFF + skey * VP + sch * 16;
    const int qlo = 49152 + wid * (2 * 6 * 1024) + lane * 16;
    { const bf16_t* qp0 = Q0 + (size_t)(wid * 32 + r32) * ldq + hi * 8; const bf16_t* qp1 = Q1 + (size_t)(wid * 32 + r32) * ldq + hi * 8;
      {
#pragma unroll
          for (int d0 = 0; d0 < ND0; ++d0) {
              *reinterpret_cast<bf16x8*>(shm + qlo + d0 * 1024) = *reinterpret_cast<const bf16x8*>(qp0 + d0 * 16);
              *reinterpret_cast<bf16x8*>(shm + qlo + (6 + d0) * 1024) = *reinterpret_cast<const bf16x8*>(qp1 + d0 * 16);
          }
      } }
    const int kfo = kperm(r32) * KP + hi * 16;
    const int vfo = VOFF + r32 * VP + hi * 16;
    const int NT = S / 64;
    u32x4 kreg, preg, vreg;
    kreg = *reinterpret_cast<const u32x4*>(kg); vreg = *reinterpret_cast<const u32x4*>(vg);
    if (DQ == 96) { if (tid < 256) preg = *reinterpret_cast<const u32x4*>(pg); }
    __syncthreads();
    *reinterpret_cast<u32x4*>(shm + kst) = kreg; *reinterpret_cast<u32x4*>(shm + vst) = vreg;
    if (DQ == 96) { if (tid < 256) *reinterpret_cast<u32x4*>(shm + pst) = preg; }
    __syncthreads();
    float m_run[2] = {0.f, 0.f}, l_run[2] = {0.f, 0.f};
    f32x16 zc;
#pragma unroll
    for (int r = 0; r < 16; ++r) zc[r] = 0.f;
    f32x16 o[2][2];
#pragma unroll
    for (int sb = 0; sb < 2; ++sb)
#pragma unroll
        for (int r = 0; r < 16; ++r) { o[sb][0][r] = 0.f; o[sb][1][r] = 0.f; }
    for (int t = 0; t < NT; ++t) {
        const unsigned char* buf = shm + (t & 1) * BUFB;
        if (t + 1 < NT) {
            kreg = *reinterpret_cast<const u32x4*>(kg + (size_t)(t + 1) * 64 * ldk1);
            vreg = *reinterpret_cast<const u32x4*>(vg + (t + 1) * 64);
            if (DQ == 96) { if (tid < 256) preg = *reinterpret_cast<const u32x4*>(pg + (size_t)(t + 1) * 64 * 32); }
        }
        const bool first = (t == 0);
        if (DQ == 64) {
            f32x16 p[2][2];
#pragma unroll
            for (int h = 0; h < 2; ++h) {
                bf16x8 kf[4], qa[2], qb[2];
#pragma unroll
                for (int dd = 0; dd < 2; ++dd) {
                    kf[2 * dd] = *reinterpret_cast<const bf16x8*>(buf + kfo + (2 * h + dd) * 32);
                    kf[2 * dd + 1] = *reinterpret_cast<const bf16x8*>(buf + kfo + 32 * KP + (2 * h + dd) * 32);
                    qa[dd] = *reinterpret_cast<const bf16x8*>(shm + qlo + (2 * h + dd) * 1024);
                    qb[dd] = *reinterpret_cast<const bf16x8*>(shm + qlo + (6 + 2 * h + dd) * 1024);
                }
                __builtin_amdgcn_sched_barrier(0);
                if (h == 0) {
                    p[0][0] = __builtin_amdgcn_mfma_f32_32x32x16_bf16(kf[0], qa[0], zc, 0, 0, 0);
                    p[0][1] = __builtin_amdgcn_mfma_f32_32x32x16_bf16(kf[1], qa[0], zc, 0, 0, 0);
                    p[1][0] = __builtin_amdgcn_mfma_f32_32x32x16_bf16(kf[0], qb[0], zc, 0, 0, 0);
                    p[1][1] = __builtin_amdgcn_mfma_f32_32x32x16_bf16(kf[1], qb[0], zc, 0, 0, 0);
                } else {
                    p[0][0] = __builtin_amdgcn_mfma_f32_32x32x16_bf16(kf[0], qa[0], p[0][0], 0, 0, 0);
                    p[0][1] = __builtin_amdgcn_mfma_f32_32x32x16_bf16(kf[1], qa[0], p[0][1], 0, 0, 0);
                    p[1][0] = __builtin_amdgcn_mfma_f32_32x32x16_bf16(kf[0], qb[0], p[1][0], 0, 0, 0);
                    p[1][1] = __builtin_amdgcn_mfma_f32_32x32x16_bf16(kf[1], qb[0], p[1][1], 0, 0, 0);
                }
                p[0][0] = __builtin_amdgcn_mfma_f32_32x32x16_bf16(kf[2], qa[1], p[0][0], 0, 0, 0);
                p[0][1] = __builtin_amdgcn_mfma_f32_32x32x16_bf16(kf[3], qa[1], p[0][1], 0, 0, 0);
                p[1][0] = __builtin_amdgcn_mfma_f32_32x32x16_bf16(kf[2], qb[1], p[1][0], 0, 0, 0);
                p[1][1] = __builtin_amdgcn_mfma_f32_32x32x16_bf16(kf[3], qb[1], p[1][1], 0, 0, 0);
                __builtin_amdgcn_sched_barrier(0);
            }
            bf16x8 vf[8];
#pragma unroll
            for (int ks = 0; ks < 4; ++ks) {
                vf[2 * ks] = *reinterpret_cast<const bf16x8*>(buf + vfo + ks * 32);
                vf[2 * ks + 1] = *reinterpret_cast<const bf16x8*>(buf + vfo + 32 * VP + ks * 32);
            }
            __builtin_amdgcn_sched_barrier(0);
            float rm[2];
#pragma unroll
            for (int sb = 0; sb < 2; ++sb) {
                const f32x16& p0 = p[sb][0]; const f32x16& p1 = p[sb][1];
                float a0 = __builtin_fmaxf(__builtin_fmaxf(p0[0], p0[1]), p1[0]), a1 = __builtin_fmaxf(__builtin_fmaxf(p0[2], p0[3]), p1[1]);
                a0 = __builtin_fmaxf(__builtin_fmaxf(a0, p1[2]), p1[3]);
#pragma unroll
                for (int r = 4; r < 16; r += 4) {
                    a0 = __builtin_fmaxf(__builtin_fmaxf(a0, p0[r]), p0[r + 1]); a1 = __builtin_fmaxf(__builtin_fmaxf(a1, p0[r + 2]), p0[r + 3]);
                    a0 = __builtin_fmaxf(__builtin_fmaxf(a0, p1[r]), p1[r + 1]); a1 = __builtin_fmaxf(__builtin_fmaxf(a1, p1[r + 2]), p1[r + 3]);
                }
                rm[sb] = xmax(__builtin_fmaxf(a0, a1));
            }
            {   const float rmc = fmaxf(rm[0], rm[1]);
                if (first || __any(rmc > THR)) {
                    const float dl = first ? rmc : fmaxf(rmc, 0.f);
                    const float al = first ? 0.f : __builtin_amdgcn_exp2f(-dl);
                    m_run[0] += dl; l_run[0] *= al; l_run[1] *= al;
#pragma unroll
                    for (int r = 0; r < 16; ++r) { zc[r] -= dl;
                        o[0][0][r] *= al; o[0][1][r] *= al; o[1][0][r] *= al; o[1][1][r] *= al;
                        p[0][0][r] -= dl; p[0][1][r] -= dl; p[1][0][r] -= dl; p[1][1][r] -= dl; }
                }
            }
#define SM_STEP(SB, PW) do { f32x16& p0 = p[SB][0]; f32x16& p1 = p[SB][1]; float ls0 = 0.f, ls1 = 0.f; \
                _Pragma("unroll") for (int r = 0; r < 16; ++r) { p0[r] = __builtin_amdgcn_exp2f(p0[r]); p1[r] = __builtin_amdgcn_exp2f(p1[r]); } \
                PW[0] = (u32x4){cvtpk(p0[0], p0[1]), cvtpk(p0[2], p0[3]), cvtpk(p0[4], p0[5]), cvtpk(p0[6], p0[7])}; \
                PW[1] = (u32x4){cvtpk(p0[8], p0[9]), cvtpk(p0[10], p0[11]), cvtpk(p0[12], p0[13]), cvtpk(p0[14], p0[15])}; \
                PW[2] = (u32x4){cvtpk(p1[0], p1[1]), cvtpk(p1[2], p1[3]), cvtpk(p1[4], p1[5]), cvtpk(p1[6], p1[7])}; \
                PW[3] = (u32x4){cvtpk(p1[8], p1[9]), cvtpk(p1[10], p1[11]), cvtpk(p1[12], p1[13]), cvtpk(p1[14], p1[15])}; \
                _Pragma("unroll") for (int k = 0; k < 4; ++k) { ls0 = dot2ones(PW[k][0], ls0); ls1 = dot2ones(PW[k][1], ls1); ls0 = dot2ones(PW[k][2], ls0); ls1 = dot2ones(PW[k][3], ls1); } \
                l_run[SB] += ls0 + ls1; } while (0)
            u32x4 pwa[4], pwb[4];
            SM_STEP(0, pwa);
            __builtin_amdgcn_sched_barrier(0);
#pragma unroll
            for (int ks = 0; ks < 4; ++ks) {
                const bf16x8 pb = __builtin_bit_cast(bf16x8, pwa[ks]);
                o[0][0] = __builtin_amdgcn_mfma_f32_32x32x16_bf16(vf[2 * ks], pb, o[0][0], 0, 0, 0);
                o[0][1] = __builtin_amdgcn_mfma_f32_32x32x16_bf16(vf[2 * ks + 1], pb, o[0][1], 0, 0, 0);
            }
            SM_STEP(1, pwb);
#pragma unroll
            for (int g = 0; g < 8; ++g) { __builtin_amdgcn_sched_group_barrier(0x008, 1, 0); __builtin_amdgcn_sched_group_barrier(0x002 | 0x400, 14, 0); }
            __builtin_amdgcn_sched_barrier(0);
#undef SM_STEP
#pragma unroll
            for (int ks = 0; ks < 4; ++ks) {
                const bf16x8 pb = __builtin_bit_cast(bf16x8, pwb[ks]);
                o[1][0] = __builtin_amdgcn_mfma_f32_32x32x16_bf16(vf[2 * ks], pb, o[1][0], 0, 0, 0);
                o[1][1] = __builtin_amdgcn_mfma_f32_32x32x16_bf16(vf[2 * ks + 1], pb, o[1][1], 0, 0, 0);
            }
            __builtin_amdgcn_sched_barrier(0);
        } else {
#define QK_STEP(SB, P0, P1) do { \
            _Pragma("unroll") for (int kh = 0; kh < 2; ++kh) { \
                bf16x8 kf[6]; \
                _Pragma("unroll") for (int dd = 0; dd < 3; ++dd) { \
                    kf[2 * dd] = *reinterpret_cast<const bf16x8*>(buf + kfo + (kh * 3 + dd) * 32); \
                    kf[2 * dd + 1] = *reinterpret_cast<const bf16x8*>(buf + kfo + 32 * KP + (kh * 3 + dd) * 32); } \
                __builtin_amdgcn_sched_barrier(0); \
                _Pragma("unroll") for (int dd = 0; dd < 3; ++dd) { \
                    const bf16x8 qf = *reinterpret_cast<const bf16x8*>(shm + qlo + ((SB) * 6 + kh * 3 + dd) * 1024); \
                    if (kh == 0 && dd == 0) { \
                        P0 = __builtin_amdgcn_mfma_f32_32x32x16_bf16(kf[0], qf, zc, 0, 0, 0); P1 = __builtin_amdgcn_mfma_f32_32x32x16_bf16(kf[1], qf, zc, 0, 0, 0); } \
                    else { P0 = __builtin_amdgcn_mfma_f32_32x32x16_bf16(kf[2 * dd], qf, P0, 0, 0, 0); P1 = __builtin_amdgcn_mfma_f32_32x32x16_bf16(kf[2 * dd + 1], qf, P1, 0, 0, 0); } } \
                __builtin_amdgcn_sched_barrier(0); } } while (0)
#define ROWMAX_S(P0, P1, RM) do { \
            float a0 = __builtin_fmaxf(__builtin_fmaxf(P0[0], P0[1]), P1[0]), a1 = __builtin_fmaxf(__builtin_fmaxf(P0[2], P0[3]), P1[1]); \
            a0 = __builtin_fmaxf(__builtin_fmaxf(a0, P1[2]), P1[3]); \
            _Pragma("unroll") for (int r = 4; r < 16; r += 4) { \
                a0 = __builtin_fmaxf(__builtin_fmaxf(a0, P0[r]), P0[r + 1]); a1 = __builtin_fmaxf(__builtin_fmaxf(a1, P0[r + 2]), P0[r + 3]); \
                a0 = __builtin_fmaxf(__builtin_fmaxf(a0, P1[r]), P1[r + 1]); a1 = __builtin_fmaxf(__builtin_fmaxf(a1, P1[r + 2]), P1[r + 3]); } \
            RM = xmax(__builtin_fmaxf(a0, a1));   } while (0)
#define SM_STEP(SB, P0, P1, PW) do { float ls0 = 0.f, ls1 = 0.f; \
            _Pragma("unroll") for (int r = 0; r < 16; ++r) { P0[r] = __builtin_amdgcn_exp2f(P0[r]); P1[r] = __builtin_amdgcn_exp2f(P1[r]); } \
            PW[0] = (u32x4){cvtpk(P0[0], P0[1]), cvtpk(P0[2], P0[3]), cvtpk(P0[4], P0[5]), cvtpk(P0[6], P0[7])}; \
            PW[1] = (u32x4){cvtpk(P0[8], P0[9]), cvtpk(P0[10], P0[11]), cvtpk(P0[12], P0[13]), cvtpk(P0[14], P0[15])}; \
            PW[2] = (u32x4){cvtpk(P1[0], P1[1]), cvtpk(P1[2], P1[3]), cvtpk(P1[4], P1[5]), cvtpk(P1[6], P1[7])}; \
            PW[3] = (u32x4){cvtpk(P1[8], P1[9]), cvtpk(P1[10], P1[11]), cvtpk(P1[12], P1[13]), cvtpk(P1[14], P1[15])}; \
            _Pragma("unroll") for (int k = 0; k < 4; ++k) { ls0 = dot2ones(PW[k][0], ls0); ls1 = dot2ones(PW[k][1], ls1); ls0 = dot2ones(PW[k][2], ls0); ls1 = dot2ones(PW[k][3], ls1); } \
            l_run[SB] += ls0 + ls1; } while (0)
            u32x4 pwa[4], pwb[4];
            f32x16 pa0, pa1, pb0, pb1;
            QK_STEP(0, pa0, pa1);
            QK_STEP(1, pb0, pb1);
            bf16x8 vf[8];
#pragma unroll
            for (int ks = 0; ks < 4; ++ks) {
                vf[2 * ks] = *reinterpret_cast<const bf16x8*>(buf + vfo + ks * 32);
                vf[2 * ks + 1] = *reinterpret_cast<const bf16x8*>(buf + vfo + 32 * VP + ks * 32);
            }
            {
                float rma, rmb; ROWMAX_S(pa0, pa1, rma); ROWMAX_S(pb0, pb1, rmb);
                const float rmc = fmaxf(rma, rmb);
                if (first || __any(rmc > THR)) {
                    const float dl = first ? rmc : fmaxf(rmc, 0.f); const float al = first ? 0.f : __builtin_amdgcn_exp2f(-dl);
                    m_run[0] += dl; l_run[0] *= al; l_run[1] *= al;
#pragma unroll
                    for (int r = 0; r < 16; ++r) { zc[r] -= dl; o[0][0][r] *= al; o[0][1][r] *= al; o[1][0][r] *= al; o[1][1][r] *= al;
                        pa0[r] -= dl; pa1[r] -= dl; pb0[r] -= dl; pb1[r] -= dl; }
                }
            }
            SM_STEP(0, pa0, pa1, pwa);
            __builtin_amdgcn_sched_barrier(0);
#pragma unroll
            for (int ks = 0; ks < 4; ++ks) {
                const bf16x8 pb = __builtin_bit_cast(bf16x8, pwa[ks]);
                o[0][0] = __builtin_amdgcn_mfma_f32_32x32x16_bf16(vf[2 * ks], pb, o[0][0], 0, 0, 0);
                o[0][1] = __builtin_amdgcn_mfma_f32_32x32x16_bf16(vf[2 * ks + 1], pb, o[0][1], 0, 0, 0);
            }
            SM_STEP(1, pb0, pb1, pwb);
#pragma unroll
            for (int g = 0; g < 8; ++g) { __builtin_amdgcn_sched_group_barrier(0x008, 1, 0); __builtin_amdgcn_sched_group_barrier(0x002 | 0x400, 14, 0); }
            __builtin_amdgcn_sched_barrier(0);
#undef QK_STEP
#undef ROWMAX_S
#undef SM_STEP
#pragma unroll
            for (int ks = 0; ks < 4; ++ks) {
                const bf16x8 pb = __builtin_bit_cast(bf16x8, pwb[ks]);
                o[1][0] = __builtin_amdgcn_mfma_f32_32x32x16_bf16(vf[2 * ks], pb, o[1][0], 0, 0, 0);
                o[1][1] = __builtin_amdgcn_mfma_f32_32x32x16_bf16(vf[2 * ks + 1], pb, o[1][1], 0, 0, 0);
            }
            __builtin_amdgcn_sched_barrier(0);
        }
        if (t + 1 < NT) {
            unsigned char* nb = shm + ((t + 1) & 1) * BUFB;
            *reinterpret_cast<u32x4*>(nb + kst) = kreg; *reinterpret_cast<u32x4*>(nb + vst) = vreg;
            if (DQ == 96) { if (tid < 256) *reinterpret_cast<u32x4*>(nb + pst) = preg; }
        }
        __syncthreads();
    }
#pragma unroll
    for (int sb = 0; sb < 2; ++sb) {
        const float lt = xsum(l_run[sb]);
        const float inv = 1.0f / lt;
        bf16_t* op = (sb == 0 ? O0 : O1) + (size_t)(wid * 32 + r32) * DM + 4 * hi;
#pragma unroll
        for (int g = 0; g < 4; ++g) {
            *reinterpret_cast<u32x2*>(op + 8 * g) = (u32x2){cvtpk(o[sb][0][4 * g] * inv, o[sb][0][4 * g + 1] * inv), cvtpk(o[sb][0][4 * g + 2] * inv, o[sb][0][4 * g + 3] * inv)};
            *reinterpret_cast<u32x2*>(op + 32 + 8 * g) = (u32x2){cvtpk(o[sb][1][4 * g] * inv, o[sb][1][4 * g + 1] * inv), cvtpk(o[sb][1][4 * g + 2] * inv, o[sb][1][4 * g + 3] * inv)};
        }
    }
}

template <int MODE>
__device__ __forceinline__ void conv_weight(const float* __restrict__ W, int K, int N, bf16_t* __restrict__ dst, int ldb,
                                            const float* __restrict__ gA, const float* __restrict__ gB, int gtid, int gthreads) {
    const int total = N * (K / 8);
    for (int i = gtid; i < total; i += gthreads) {
        const int kq = i / N, n = i - kq * N, k0 = kq * 8;
        float v[8];
#pragma unroll
        for (int j = 0; j < 8; ++j) {
            float w = W[(size_t)(k0 + j) * N + n];
            if (MODE == 1) w *= gA[k0 + j];
            if (MODE == 2) w *= (k0 + j < 512) ? gA[k0 + j] : gB[k0 + j - 512];
            v[j] = w;
        }
        int row = n;
        if (MODE == 3) row = (n >> 7) * 256 + (n & 127);
        if (MODE == 4) row = (n >> 7) * 256 + 128 + (n & 127);
        *reinterpret_cast<u32x4*>(dst + (size_t)row * ldb + k0) = (u32x4){cvtpk(v[0], v[1]), cvtpk(v[2], v[3]), cvtpk(v[4], v[5]), cvtpk(v[6], v[7])};
    }
}

#define LAS __attribute__((address_space(3)))
#define XB_TMO      128
#define XB_XCNT(j)  (256  + 64 * (j))
#define XB_XSUB(j)  (1280 + 64 * (j))
#define XB_XGEN(j)  (2304 + 64 * (j))
#define XB_TOP      3328
#define XB_TOPGEN   3392
#define XCD_BAR_WORDS 3456
#define XB_SPIN_CAP (1u << 18)
__device__ __forceinline__ unsigned xb_ld(unsigned* p)              { return __hip_atomic_load(p, __ATOMIC_RELAXED, __HIP_MEMORY_SCOPE_AGENT); }
__device__ __forceinline__ unsigned xb_add(unsigned* p, unsigned v) { return __hip_atomic_fetch_add(p, v, __ATOMIC_RELAXED, __HIP_MEMORY_SCOPE_AGENT); }
__device__ __forceinline__ unsigned xb_xcc_id() { return (unsigned)__builtin_amdgcn_s_getreg((3 << 11) | 20) & 0xFu; }
#define XB_SPIN(cond, bar) do { unsigned _sp = 0; while (cond) { __builtin_amdgcn_s_sleep(1); \
    if ((++_sp & 255u) == 0u) { if (xb_ld(&(bar)[XB_TMO])) break; if (_sp > XB_SPIN_CAP) { atomicAdd(&(bar)[XB_TMO], 1u); break; } } } } while (0)
__device__ __forceinline__ void xcd_barrier_complete(unsigned* bar, unsigned x, unsigned& nloc, unsigned& nx) {
    const unsigned G = gridDim.x * gridDim.y * gridDim.z;
    unsigned sum, cnt, mine, sp = 0u;
    for (;;) {
        sum = 0u; cnt = 0u; mine = 0u;
#pragma unroll
        for (unsigned j = 0; j < 16; ++j) { const unsigned c = xb_ld(&bar[XB_XCNT(j)]); sum += c; cnt += (c > 0u) ? 1u : 0u; mine = (j == x) ? c : mine; }
        if (sum == G) break;
        __builtin_amdgcn_s_sleep(1);
        if ((++sp & 255u) == 0u) { if (xb_ld(&bar[XB_TMO])) break; if (sp > XB_SPIN_CAP) { atomicAdd(&bar[XB_TMO], 1u); break; } }
    }
    nloc = mine > 0u ? mine : 1u; nx = cnt > 0u ? cnt : 1u;
}
__device__ __forceinline__ void xcd_barrier(unsigned* bar, unsigned x, volatile LAS unsigned* st, bool leader) {
    asm volatile("s_waitcnt vmcnt(0)" ::: "memory");
    __syncthreads();
    if (leader) {
        __builtin_amdgcn_s_waitcnt(0);
        unsigned nloc = st[0], nx = st[1];
        if (nloc == 0u) { xcd_barrier_complete(bar, x, nloc, nx); st[0] = nloc; st[1] = nx; }
        const unsigned old = xb_add(&bar[XB_XSUB(x)], 1u);
        const unsigned gen = old / nloc;
        if (old + 1u == (gen + 1u) * nloc) {
            __builtin_amdgcn_fence(__ATOMIC_RELEASE, "agent");
            asm volatile("s_waitcnt vmcnt(0)" ::: "memory");
            const unsigned og = xb_add(&bar[XB_TOP], 1u);
            const unsigned tg = og / nx;
            if (og + 1u == (tg + 1u) * nx) xb_add(&bar[XB_TOPGEN], 1u);
            else XB_SPIN(xb_ld(&bar[XB_TOPGEN]) == tg, bar);
            __builtin_amdgcn_fence(__ATOMIC_ACQUIRE, "agent");
            xb_add(&bar[XB_XGEN(x)], 1u);
            asm volatile("s_waitcnt vmcnt(0)" ::: "memory");
        } else {
            XB_SPIN(xb_ld(&bar[XB_XGEN(x)]) == gen, bar);
            __builtin_amdgcn_fence(__ATOMIC_ACQUIRE, "agent");
            asm volatile("s_waitcnt vmcnt(0)" ::: "memory");
        }
    }
    __syncthreads();
}

__global__ void __launch_bounds__(512) fwd_kernel(Params p) {
    extern __shared__ __attribute__((aligned(16))) unsigned char lds[];
    cg::grid_group grid = cg::this_grid();
    const int tid = threadIdx.x, lane = tid & 63, wv = tid >> 6;
    const int G = gridDim.x, bx = blockIdx.x;
    const int vcu = ((G & 7) == 0) ? (bx % 8) * (G / 8) + bx / 8 : bx;
    unsigned char* ws = p.ws;
    const float* xp = p.in[0]; const float* xs = p.in[1];
    bf16_t* W1t = (bf16_t*)(ws + WS_W1T); bf16_t* Wuqt = (bf16_t*)(ws + WS_WUQT); bf16_t* Wukvt = (bf16_t*)(ws + WS_WUKVT);
    bf16_t* Woutt = (bf16_t*)(ws + WS_WOUTT); bf16_t* Wgut = (bf16_t*)(ws + WS_WGUT); bf16_t* Wdnt = (bf16_t*)(ws + WS_WDNT);
    float* mod = (float*)(ws + WS_MOD);
    float* cosA = (float*)(ws + WS_COSA); float* sinA = (float*)(ws + WS_SINA); float* cosB = (float*)(ws + WS_COSB); float* sinB = (float*)(ws + WS_SINB);
    float* rsq = (float*)(ws + WS_RSQ); float* rskv = (float*)(ws + WS_RSKV);
    bf16_t* U = (bf16_t*)(ws + WS_U); bf16_t* H = (bf16_t*)(ws + WS_H); bf16_t* Ob = (bf16_t*)(ws + WS_O);
    bf16_t* Qa = (bf16_t*)(ws + WS_QA); bf16_t* Ka = (bf16_t*)(ws + WS_KA); bf16_t* Vta = (bf16_t*)(ws + WS_VTA);
    bf16_t* Qm = (bf16_t*)(ws + WS_QM); bf16_t* Kn = (bf16_t*)(ws + WS_KN); bf16_t* Kpe = (bf16_t*)(ws + WS_KPE); bf16_t* Vtm = (bf16_t*)(ws + WS_VTM);
    bf16_t* F = (bf16_t*)(ws + WS_F);
    float* out = p.out;
    const int lo = p.lo, hi_ = p.hi;
#ifndef PH_MASK
#define PH_MASK 0xFFF
#endif
#define IN(k) (((PH_MASK >> (k)) & 1) && lo <= (k) && (k) < hi_)
#define SEAM(k) do { if (IN(k) && IN((k) + 1)) { if ((k) == 0) grid.sync(); else xcd_barrier(xbar, xcc, xst, tid == 0); } } while (0)
    unsigned* const xbar = (unsigned*)(p.ws + WS_BAR);
    volatile LAS unsigned* const xst = (volatile LAS unsigned*)((LAS unsigned char*)lds + LDS_XST);
    const unsigned xcc = xb_xcc_id();
    if (tid == 0) { xst[0] = 0u; xst[1] = 0u; (void)xb_add(&xbar[XB_XCNT(xcc)], 1u); }
    __syncthreads();

    if (IN(0)) {
        float* s_c = (float*)lds;
        float* red = (float*)(lds + 65536);
        const float* cpr = p.in[2]; const float* csm = p.in[3]; const float* w_ada = p.in[4]; const float* b_ada = p.in[5];
        for (int cb = bx; cb < 192; cb += G) {
            for (int i = tid; i < 16 * 1024; i += 512) {
                const int b = i >> 10, k = i & 1023; const float c = (b < 8) ? cpr[b * 1024 + k] : csm[(b - 8) * 1024 + k];
                s_c[i] = c / (1.0f + __expf(-c));
            }
            __syncthreads();
            const int kgp = tid >> 5, cl = tid & 31, col = cb * 32 + cl;
            float a[16];
#pragma unroll
            for (int b = 0; b < 16; ++b) a[b] = 0.f;
            for (int k = kgp * 64; k < kgp * 64 + 64; ++k) {
                const float w = w_ada[(size_t)k * 6144 + col];
#pragma unroll
                for (int b = 0; b < 16; ++b) a[b] += s_c[b * 1024 + k] * w;
            }
#pragma unroll
            for (int b = 0; b < 16; ++b) red[(kgp * 16 + b) * 32 + cl] = a[b];
            __syncthreads();
            { const int b = tid >> 5; float s = 0.f;
#pragma unroll
              for (int k2 = 0; k2 < 16; ++k2) s += red[(k2 * 16 + b) * 32 + cl];
              mod[b * 6144 + col] = s + b_ada[col]; }
            __syncthreads();
        }
        const int gtid = bx * 512 + tid, gth = G * 512;
        for (int i = gtid; i < 8192 * 48; i += gth) {
            const int s = i / 48, j = i - s * 48;
            int ii, n; if (j < 32) { ii = j; n = 16; } else { ii = j - 32; n = 8; }
            const int pos = (ii < n) ? (s >> 6) : (s & 63); const int fi = (ii < n) ? ii : ii - n;
            const float inv = exp2f(-((float)fi / (float)n) * 13.287712379549449f);
            const float ang = (float)pos * inv;
            const double rev = (double)ang * 0.15915494309189535; const float fr_ = (float)(rev - floor(rev));
            const float cv = __builtin_amdgcn_cosf(fr_), sv = __builtin_amdgcn_sinf(fr_);
            if (j < 32) { cosA[s * 32 + ii] = cv; sinA[s * 32 + ii] = sv; } else { cosB[s * 16 + ii] = cv; sinB[s * 16 + ii] = sv; }
        }
        conv_weight<0>(p.in[6], 1024, 1184, W1t, 1024, nullptr, nullptr, gtid, gth);
        for (int i = gtid; i < 96 * 1024 / 8; i += gth) *reinterpret_cast<u32x4*>(W1t + (size_t)1184 * 1024 + (size_t)i * 8) = (u32x4){0u, 0u, 0u, 0u};
        conv_weight<1>(p.in[10], 256, 768, Wuqt, 256, p.in[9], nullptr, gtid, gth);
        conv_weight<1>(p.in[12], 128, 1024, Wukvt, 256, p.in[11], nullptr, gtid, gth);
        for (int i = gtid; i < 1024 * 16; i += gth) { const int r = i >> 4, c = i & 15; *reinterpret_cast<u32x4*>(Wukvt + (size_t)r * 256 + 128 + c * 8) = (u32x4){0u, 0u, 0u, 0u}; }
        conv_weight<2>(p.in[15], 1024, 1024, Woutt, 1024, p.in[13], p.in[14], gtid, gth);
        conv_weight<3>(p.in[18], 1024, 2816, Wgut, 1024, nullptr, nullptr, gtid, gth);
        conv_weight<4>(p.in[19], 1024, 2816, Wgut, 1024, nullptr, nullptr, gtid, gth);
        conv_weight<0>(p.in[20], 2816, 1024, Wdnt, 2816, nullptr, nullptr, gtid, gth);
    }
    SEAM(0);

    if (IN(1)) {
        constexpr int NR = 4;
        for (int t0 = bx * 8 + wv; t0 < T; t0 += NR * G * 8) {
            f32x4 v[NR][4];
#pragma unroll
            for (int rr = 0; rr < NR; ++rr) {
                const int t = t0 + rr * G * 8; const float* xr = xrow(xp, xs, t < T ? t : t0);
#pragma unroll
                for (int c = 0; c < 4; ++c) v[rr][c] = *reinterpret_cast<const f32x4*>(xr + c * 256 + lane * 4);
            }
#pragma unroll
            for (int rr = 0; rr < NR; ++rr) {
                const int t = t0 + rr * G * 8;
                float s = 0.f;
#pragma unroll
                for (int c = 0; c < 4; ++c) s += (v[rr][c][0] + v[rr][c][1]) + (v[rr][c][2] + v[rr][c][3]);
                const float mean = wave_sum(s) * (1.0f / 1024.0f);
                float q = 0.f;
#pragma unroll
                for (int c = 0; c < 4; ++c) { v[rr][c] = v[rr][c] - mean; q += (v[rr][c][0] * v[rr][c][0] + v[rr][c][1] * v[rr][c][1]) + (v[rr][c][2] * v[rr][c][2] + v[rr][c][3] * v[rr][c][3]); }
                const float rstd = rsqrtf(wave_sum(q) * (1.0f / 1024.0f) + EPS);
                if (t < T) {
                    int b, S, tok0; tokinfo(t, b, S, tok0);
                    const float* md = mod + b * 6144;
#pragma unroll
                    for (int c = 0; c < 4; ++c) {
                        const int col = c * 256 + lane * 4;
                        const f32x4 sh = *reinterpret_cast<const f32x4*>(md + col), sc = *reinterpret_cast<const f32x4*>(md + 1024 + col);
                        const f32x4 y = v[rr][c] * rstd * (sc + 1.0f) + sh;
                        *reinterpret_cast<u32x2*>(U + (size_t)t * DM + col) = (u32x2){cvtpk(y[0], y[1]), cvtpk(y[2], y[3])};
                    }
                }
            }
        }
    }
    SEAM(1);

    if (IN(2)) {
        int pm, pn;
        for (int i = 0; tile_next(i, G, bx, NMT, 5, pm, pn); ++i) {
            f32x4 acc[2][2][4][2];
            const int brow = pm * 256, bcol = pn * 256;
            int b, S, tok0; tokinfo(brow, b, S, tok0);
            if (pn == 2) {
                gemm_core<false>(lds, U, DM, W1t, DM, 16, brow, bcol, acc);
                EPI_GEOM
#pragma unroll
                for (int ai = 0; ai < 2; ++ai)
#pragma unroll
                    for (int m = 0; m < 4; ++m) {
                        asm volatile("" ::: "memory"); const int row = brow + ai * 128 + wr * 64 + m * 16 + fq * 4;
#pragma unroll
                        for (int bj = 0; bj < 2; ++bj)
#pragma unroll
                            for (int n = 0; n < 2; ++n) {
                                const int col = bcol + bj * 128 + wc * 32 + n * 16 + fr; const f32x4 v = acc[ai][bj][m][n];
                                if (bj == 1) {
                                    const size_t off = (size_t)tok0 * 128 + (size_t)(col - 640) * S + (row - tok0);
                                    *reinterpret_cast<u32x2*>(Vta + off) = (u32x2){cvtpk(v[0], v[1]), cvtpk(v[2], v[3])};
                                } else {
#pragma unroll
                                    for (int j = 0; j < 4; ++j) H[(size_t)(row + j) * HP + col] = f2bf(v[j]);
                                }
                            }
                    }
            } else {
                gemm_core<true>(lds, U, DM, W1t, DM, 16, brow, bcol, acc);
                EPI_GEOM
#pragma unroll
                for (int ai = 0; ai < 2; ++ai)
#pragma unroll
                    for (int m = 0; m < 4; ++m) {
                        asm volatile("" ::: "memory"); const int row = brow + ai * 128 + wr * 64 + m * 16 + fr;
#pragma unroll
                        for (int bj = 0; bj < 2; ++bj)
#pragma unroll
                            for (int n = 0; n < 2; ++n) {
                                const int c0 = bcol + bj * 128 + wc * 32 + n * 16 + fq * 4; const f32x4 v = acc[ai][bj][m][n];
                                *reinterpret_cast<u32x2*>(H + (size_t)row * HP + c0) = (u32x2){cvtpk(v[0], v[1]), cvtpk(v[2], v[3])};
                            }
                    }
                if (pn >= 3) {
                    float* part = (float*)(ws + (pn == 3 ? WS_PQ : WS_PKV));
#pragma unroll
                    for (int ai = 0; ai < 2; ++ai)
#pragma unroll
                        for (int m = 0; m < 4; ++m) {
                            const int row = brow + ai * 128 + wr * 64 + m * 16 + fr;
                            float sq = 0.f;
#pragma unroll
                            for (int n = 0; n < 2; ++n) {
                                const f32x4 v0 = acc[ai][0][m][n], v1 = acc[ai][1][m][n];
                                sq += (v0[0] * v0[0] + v0[1] * v0[1]) + (v0[2] * v0[2] + v0[3] * v0[3]);
                                if (pn == 3) sq += (v1[0] * v1[0] + v1[1] * v1[1]) + (v1[2] * v1[2] + v1[3] * v1[3]);
                            }
                            sq += __shfl_xor(sq, 16); sq += __shfl_xor(sq, 32);
                            part[(size_t)row * 4 + wc] = sq;
                        }
                }
            }
        }
    }
    SEAM(2);

    if (IN(3)) {
        const float* gq = p.in[7]; const float* gk = p.in[8];
        for (int t = bx * 8 + wv; t < T; t += G * 8) {
            int b, S, tok0; tokinfo(t, b, S, tok0); const int s = t - tok0;
            const bf16_t* hr = H + (size_t)t * HP;
            if (lane < 40) {
                const int hh = lane >> 2, c = lane & 3; const bool isq = hh < 8;
                const u32x4 a1 = *reinterpret_cast<const u32x4*>(hr + hh * 64 + c * 8), a2 = *reinterpret_cast<const u32x4*>(hr + hh * 64 + 32 + c * 8);
                float x1[8], x2[8]; float ss = 0.f;
#pragma unroll
                for (int e = 0; e < 4; ++e) {
                    x1[2 * e] = __uint_as_float(a1[e] << 16); x1[2 * e + 1] = __uint_as_float(a1[e] & 0xffff0000u);
                    x2[2 * e] = __uint_as_float(a2[e] << 16); x2[2 * e + 1] = __uint_as_float(a2[e] & 0xffff0000u);
                }
#pragma unroll
                for (int e = 0; e < 8; ++e) ss += x1[e] * x1[e] + x2[e] * x2[e];
                ss += __shfl_xor(ss, 1); ss += __shfl_xor(ss, 2);
                const float rstd = rsqrtf(ss * (1.0f / 64.0f) + EPS);
                const float* g = isq ? gq : gk; const float scl = isq ? C2A : 1.0f;
                float o1[8], o2[8];
#pragma unroll
                for (int e = 0; e < 8; ++e) {
                    const int d1 = c * 8 + e;
                    const float a = x1[e] * rstd * g[d1], bb = x2[e] * rstd * g[d1 + 32];
                    const float cs = cosA[s * 32 + d1], sn = sinA[s * 32 + d1];
                    o1[e] = (a * cs - bb * sn) * scl; o2[e] = (a * sn + bb * cs) * scl;
                }
                bf16_t* dst = isq ? (Qa + (size_t)t * 512 + hh * 64 + c * 8) : (Ka + (size_t)t * 128 + (hh - 8) * 64 + c * 8);
                *reinterpret_cast<u32x4*>(dst) = (u32x4){cvtpk(o1[0], o1[1]), cvtpk(o1[2], o1[3]), cvtpk(o1[4], o1[5]), cvtpk(o1[6], o1[7])};
                *reinterpret_cast<u32x4*>(dst + 32) = (u32x4){cvtpk(o2[0], o2[1]), cvtpk(o2[2], o2[3]), cvtpk(o2[4], o2[5]), cvtpk(o2[6], o2[7])};
            }
            if (lane < 2) {
                const u32x4 a1 = *reinterpret_cast<const u32x4*>(hr + 1152 + lane * 8), a2 = *reinterpret_cast<const u32x4*>(hr + 1152 + 16 + lane * 8);
                float o1[8], o2[8];
#pragma unroll
                for (int e = 0; e < 4; ++e) {
#pragma unroll
                    for (int h2 = 0; h2 < 2; ++h2) {
                        const int ee = 2 * e + h2, i = lane * 8 + ee;
                        const float a = h2 ? __uint_as_float(a1[e] & 0xffff0000u) : __uint_as_float(a1[e] << 16);
                        const float bb = h2 ? __uint_as_float(a2[e] & 0xffff0000u) : __uint_as_float(a2[e] << 16);
                        const float cs = cosB[s * 16 + i], sn = sinB[s * 16 + i];
                        o1[ee] = a * cs - bb * sn; o2[ee] = a * sn + bb * cs;
                    }
                }
                bf16_t* dst = Kpe + (size_t)t * 32 + lane * 8;
                *reinterpret_cast<u32x4*>(dst) = (u32x4){cvtpk(o1[0], o1[1]), cvtpk(o1[2], o1[3]), cvtpk(o1[4], o1[5]), cvtpk(o1[6], o1[7])};
                *reinterpret_cast<u32x4*>(dst + 16) = (u32x4){cvtpk(o2[0], o2[1]), cvtpk(o2[2], o2[3]), cvtpk(o2[4], o2[5]), cvtpk(o2[6], o2[7])};
            }
        }
    }

    if (IN(4)) {
        int pm, pn;
        for (int i = 0; tile_next(i, G, bx, NMT, 7, pm, pn); ++i) {
            f32x4 acc[2][2][4][2];
            const int brow = pm * 256;
            const bool isq = pn < 3;
            const bf16_t* A = H + (isq ? 768 : 1024);
            const bf16_t* Bt = isq ? Wuqt : Wukvt;
            const int bcol = isq ? pn * 256 : (pn - 3) * 256;
            int b, S, tok0; tokinfo(brow, b, S, tok0);
            if (isq) {
                gemm_core<true>(lds, A, HP, Bt, 256, 4, brow, bcol, acc);
                EPI_GEOM
#pragma unroll
                for (int ai = 0; ai < 2; ++ai)
#pragma unroll
                    for (int m = 0; m < 4; ++m) {
                        asm volatile("" ::: "memory"); const int row = brow + ai * 128 + wr * 64 + m * 16 + fr;
                        const f32x4 pq = *reinterpret_cast<const f32x4*>((const float*)(ws + WS_PQ) + (size_t)row * 4);
                        const float rs = rsqrtf(((pq[0] + pq[1]) + (pq[2] + pq[3])) * (1.0f / 256.0f) + EPS) * C2M; const int sp = row - tok0;
                        const f32x4 cs = *reinterpret_cast<const f32x4*>(cosB + sp * 16 + fq * 4), sn = *reinterpret_cast<const f32x4*>(sinB + sp * 16 + fq * 4);
#pragma unroll
                        for (int bj = 0; bj < 2; ++bj) {
                            const int g32 = pn * 8 + bj * 4 + wc; const bool isrope = (g32 % 3) == 2; const int colb = g32 * 32 + fq * 4;
                            f32x4 v0 = acc[ai][bj][m][0] * rs, v1 = acc[ai][bj][m][1] * rs;
                            if (isrope) { const f32x4 ra = v0 * cs - v1 * sn, rb = v0 * sn + v1 * cs; v0 = ra; v1 = rb; }
                            *reinterpret_cast<u32x2*>(Qm + (size_t)row * 768 + colb) = (u32x2){cvtpk(v0[0], v0[1]), cvtpk(v0[2], v0[3])};
                            *reinterpret_cast<u32x2*>(Qm + (size_t)row * 768 + colb + 16) = (u32x2){cvtpk(v1[0], v1[1]), cvtpk(v1[2], v1[3])};
                        }
                    }
            } else {
                gemm_core<false>(lds, A, HP, Bt, 256, 4, brow, bcol, acc);
                EPI_GEOM
#pragma unroll
                for (int ai = 0; ai < 2; ++ai)
#pragma unroll
                    for (int m = 0; m < 4; ++m) {
                        asm volatile("" ::: "memory"); const int row = brow + ai * 128 + wr * 64 + m * 16 + fq * 4;
                        float rs[4];
#pragma unroll
                        for (int j = 0; j < 4; ++j) { const f32x4 pk = *reinterpret_cast<const f32x4*>((const float*)(ws + WS_PKV) + (size_t)(row + j) * 4); rs[j] = rsqrtf(((pk[0] + pk[1]) + (pk[2] + pk[3])) * (1.0f / 128.0f) + EPS); }
#pragma unroll
                        for (int bj = 0; bj < 2; ++bj) {
                            const int head = (pn - 3) * 2 + bj;
#pragma unroll
                            for (int n = 0; n < 2; ++n) {
                                const int within = wc * 32 + n * 16 + fr; const f32x4 v = acc[ai][bj][m][n];
                                if (wc < 2) {
#pragma unroll
                                    for (int j = 0; j < 4; ++j) Kn[(size_t)(row + j) * 512 + head * 64 + within] = f2bf(v[j] * rs[j]);
                                } else {
                                    const size_t off = (size_t)tok0 * 512 + (size_t)(head * 64 + within - 64) * S + (row - tok0);
                                    *reinterpret_cast<u32x2*>(Vtm + off) = (u32x2){cvtpk(v[0] * rs[0], v[1] * rs[1]), cvtpk(v[2] * rs[2], v[3] * rs[3])};
                                }
                            }
                        }
                    }
            }
        }
    }
    SEAM(4);

    if (IN(5)) {
#ifndef NO_MLA
        for (int u = vcu; u < 1280; u += G) {
            const bool smp = u < 1024; const int idx = smp ? u : u - 1024;
            const int S = smp ? 8192 : 2048;
            const int nqb = S / 512, qb = idx % nqb, head = (idx / nqb) & 7, bl = idx / (nqb * 8);
            const int tok0 = smp ? TP + bl * 8192 : bl * 2048, q0 = tok0 + qb * 512;
            const bf16_t* q = Qm + (size_t)q0 * 768 + head * 96; bf16_t* o = Ob + (size_t)q0 * DM + 512 + head * 64;
            attn_unit2<96>(lds, q, q + (size_t)256 * 768, 768, Kn + (size_t)tok0 * 512 + head * 64, 512, Kpe + (size_t)tok0 * 32,
                           Vtm + (size_t)tok0 * 512 + (size_t)head * 64 * S, S, o, o + (size_t)256 * DM);
        }
#endif
#ifndef NO_GQA
        for (int u = vcu; u < 1280; u += G) {
            const bool smp = u < 1024; const int idx = smp ? u : u - 1024;
            const int S = smp ? 8192 : 2048;
            const int nqb = S / 256, qb = idx % nqb, hp = (idx / nqb) & 3, bl = idx / (nqb * 4);
            const int kvh = hp >> 1, head = hp * 2;
            const int tok0 = smp ? TP + bl * 8192 : bl * 2048, q0 = tok0 + qb * 256;
            const bf16_t* q = Qa + (size_t)q0 * 512 + head * 64; bf16_t* o = Ob + (size_t)q0 * DM + head * 64;
            attn_unit2<64>(lds, q, q + 64, 512, Ka + (size_t)tok0 * 128 + kvh * 64, 128, nullptr,
                           Vta + (size_t)tok0 * 128 + (size_t)kvh * 64 * S, S, o, o + 64);
        }
#endif
    }
    SEAM(5);

    if (IN(6)) {
        constexpr int NR = 4;
        for (int t0 = bx * 8 + wv; t0 < T; t0 += NR * G * 8) {
            u32x4 ra[NR], rc[NR];
#pragma unroll
            for (int rr = 0; rr < NR; ++rr) {
                const int t = t0 + rr * G * 8; const bf16_t* orow = Ob + (size_t)(t < T ? t : t0) * DM + lane * 16;
                ra[rr] = *reinterpret_cast<const u32x4*>(orow); rc[rr] = *reinterpret_cast<const u32x4*>(orow + 8);
            }
#pragma unroll
            for (int rr = 0; rr < NR; ++rr) {
                const int t = t0 + rr * G * 8;
                float x[16];
#pragma unroll
                for (int e = 0; e < 4; ++e) { x[2 * e] = __uint_as_float(ra[rr][e] << 16); x[2 * e + 1] = __uint_as_float(ra[rr][e] & 0xffff0000u); x[8 + 2 * e] = __uint_as_float(rc[rr][e] << 16); x[8 + 2 * e + 1] = __uint_as_float(rc[rr][e] & 0xffff0000u); }
                float ss = 0.f;
#pragma unroll
                for (int e = 0; e < 16; ++e) ss += x[e] * x[e];
#pragma unroll
                for (int o = 16; o >= 1; o >>= 1) ss += __shfl_xor(ss, o);
                const float rstd = rsqrtf(ss * (1.0f / 512.0f) + EPS);
#pragma unroll
                for (int e = 0; e < 16; ++e) x[e] *= rstd;
                if (t < T) {
                    bf16_t* orow = Ob + (size_t)t * DM + lane * 16;
                    *reinterpret_cast<u32x4*>(orow) = (u32x4){cvtpk(x[0], x[1]), cvtpk(x[2], x[3]), cvtpk(x[4], x[5]), cvtpk(x[6], x[7])};
                    *reinterpret_cast<u32x4*>(orow + 8) = (u32x4){cvtpk(x[8], x[9]), cvtpk(x[10], x[11]), cvtpk(x[12], x[13]), cvtpk(x[14], x[15])};
                }
            }
        }
    }
    SEAM(6);

    if (IN(7)) {
        int pm, pn;
        for (int i = 0; tile_next(i, G, bx, NMT, 4, pm, pn); ++i) {
            f32x4 acc[2][2][4][2];
            const int brow = pm * 256, bcol = pn * 256;
            gemm_core<true>(lds, Ob, DM, Woutt, DM, 16, brow, bcol, acc);
            EPI_GEOM
            int b, S, tok0; tokinfo(brow, b, S, tok0);
            const float* g1 = mod + b * 6144 + 2048;
            const int cl = wc * 32 + fq * 4;
            f32x4 gv[2][2], xv[2][2][2];
#pragma unroll
            for (int bj = 0; bj < 2; ++bj)
#pragma unroll
                for (int n = 0; n < 2; ++n) gv[bj][n] = *reinterpret_cast<const f32x4*>(g1 + bcol + bj * 128 + n * 16 + cl);
            { const float* xr = xrow(xp, xs, brow + wr * 64 + fr);
#pragma unroll
              for (int bj = 0; bj < 2; ++bj)
#pragma unroll
                  for (int n = 0; n < 2; ++n) xv[0][bj][n] = *reinterpret_cast<const f32x4*>(xr + bcol + bj * 128 + n * 16 + cl); }
#pragma unroll
            for (int it = 0; it < 8; ++it) {
                const int ai = it >> 2, m = it & 3;
                if (it + 1 < 8) {
                    const float* xr = xrow(xp, xs, brow + ((it + 1) >> 2) * 128 + wr * 64 + ((it + 1) & 3) * 16 + fr);
#pragma unroll
                    for (int bj = 0; bj < 2; ++bj)
#pragma unroll
                        for (int n = 0; n < 2; ++n) xv[(it + 1) & 1][bj][n] = *reinterpret_cast<const f32x4*>(xr + bcol + bj * 128 + n * 16 + cl);
                }
                const int row = brow + ai * 128 + wr * 64 + m * 16 + fr;
#pragma unroll
                for (int bj = 0; bj < 2; ++bj)
#pragma unroll
                    for (int n = 0; n < 2; ++n)
                        *reinterpret_cast<f32x4*>(out + (size_t)row * DM + bcol + bj * 128 + n * 16 + cl) = xv[it & 1][bj][n] * ALPHA + gv[bj][n] * acc[ai][bj][m][n];
                asm volatile("" ::: "memory");
            }
        }
    }
    SEAM(7);

    if (IN(8)) {
        const float* l1g = p.in[16]; const float* l1b = p.in[17];
        constexpr int NR = 4;
        for (int t0 = bx * 8 + wv; t0 < T; t0 += NR * G * 8) {
            f32x4 v[NR][4];
#pragma unroll
            for (int rr = 0; rr < NR; ++rr) {
                const int t = t0 + rr * G * 8; const float* orow = out + (size_t)(t < T ? t : t0) * DM;
#pragma unroll
                for (int c = 0; c < 4; ++c) v[rr][c] = *reinterpret_cast<const f32x4*>(orow + c * 256 + lane * 4);
            }
#pragma unroll
            for (int rr = 0; rr < NR; ++rr) {
                const int t = t0 + rr * G * 8;
                float* orow = out + (size_t)t * DM;
                float s = 0.f;
#pragma unroll
                for (int c = 0; c < 4; ++c) s += (v[rr][c][0] + v[rr][c][1]) + (v[rr][c][2] + v[rr][c][3]);
                float mean = wave_sum(s) * (1.0f / 1024.0f);
                float q = 0.f;
#pragma unroll
                for (int c = 0; c < 4; ++c) { v[rr][c] = v[rr][c] - mean; q += (v[rr][c][0] * v[rr][c][0] + v[rr][c][1] * v[rr][c][1]) + (v[rr][c][2] * v[rr][c][2] + v[rr][c][3] * v[rr][c][3]); }
                float rstd = rsqrtf(wave_sum(q) * (1.0f / 1024.0f) + EPS);
                s = 0.f;
#pragma unroll
                for (int c = 0; c < 4; ++c) {
                    const int col = c * 256 + lane * 4;
                    v[rr][c] = v[rr][c] * rstd * *reinterpret_cast<const f32x4*>(l1g + col) + *reinterpret_cast<const f32x4*>(l1b + col);
                    if (t < T) *reinterpret_cast<f32x4*>(orow + col) = v[rr][c];
                    s += (v[rr][c][0] + v[rr][c][1]) + (v[rr][c][2] + v[rr][c][3]);
                }
                mean = wave_sum(s) * (1.0f / 1024.0f);
                q = 0.f;
#pragma unroll
                for (int c = 0; c < 4; ++c) { v[rr][c] = v[rr][c] - mean; q += (v[rr][c][0] * v[rr][c][0] + v[rr][c][1] * v[rr][c][1]) + (v[rr][c][2] * v[rr][c][2] + v[rr][c][3] * v[rr][c][3]); }
                rstd = rsqrtf(wave_sum(q) * (1.0f / 1024.0f) + EPS);
                if (t < T) {
                    int b, S, tok0; tokinfo(t, b, S, tok0);
                    const float* md = mod + b * 6144;
#pragma unroll
                    for (int c = 0; c < 4; ++c) {
                        const int col = c * 256 + lane * 4;
                        const f32x4 sh = *reinterpret_cast<const f32x4*>(md + 3072 + col), sc = *reinterpret_cast<const f32x4*>(md + 4096 + col);
                        const f32x4 y = v[rr][c] * rstd * (sc + 1.0f) + sh;
                        *reinterpret_cast<u32x2*>(U + (size_t)t * DM + col) = (u32x2){cvtpk(y[0], y[1]), cvtpk(y[2], y[3])};
                    }
                }
            }
        }
    }
    SEAM(8);

    if (IN(9)) {
        int pm, pn;
        for (int i = 0; tile_next(i, G, bx, NMT, 22, pm, pn); ++i) {
            f32x4 acc[2][2][4][2];
            const int brow = pm * 256, bcol = pn * 256;
            gemm_core<true>(lds, U, DM, Wgut, DM, 16, brow, bcol, acc);
            EPI_GEOM
#pragma unroll
            for (int ai = 0; ai < 2; ++ai)
#pragma unroll
                for (int m = 0; m < 4; ++m) {
                    asm volatile("" ::: "memory"); const int row = brow + ai * 128 + wr * 64 + m * 16 + fr;
#pragma unroll
                    for (int n = 0; n < 2; ++n) {
                        const int c0 = pn * 128 + wc * 32 + n * 16 + fq * 4; const f32x4 g = acc[ai][0][m][n], uu = acc[ai][1][m][n];
                        float f[4];
#pragma unroll
                        for (int j = 0; j < 4; ++j) {
                            const float e = __builtin_amdgcn_exp2f(-LOG2E * g[j]);
                            f[j] = g[j] * __builtin_amdgcn_rcpf(1.0f + e) * uu[j];
                        }
                        *reinterpret_cast<u32x2*>(F + (size_t)row * DFF + c0) = (u32x2){cvtpk(f[0], f[1]), cvtpk(f[2], f[3])};
                    }
                }
        }
    }
    SEAM(9);

    if (IN(10)) {
        int pm, pn;
        for (int i = 0; tile_next(i, G, bx, NMT, 4, pm, pn); ++i) {
            f32x4 acc[2][2][4][2];
            const int brow = pm * 256, bcol = pn * 256;
            gemm_core<true>(lds, F, DFF, Wdnt, DFF, 44, brow, bcol, acc);
            EPI_GEOM
            int b, S, tok0; tokinfo(brow, b, S, tok0);
            const float* g2 = mod + b * 6144 + 5120;
            const int cl = wc * 32 + fq * 4;
            f32x4 gv[2][2], xv[2][2][2];
#pragma unroll
            for (int bj = 0; bj < 2; ++bj)
#pragma unroll
                for (int n = 0; n < 2; ++n) gv[bj][n] = *reinterpret_cast<const f32x4*>(g2 + bcol + bj * 128 + n * 16 + cl);
            { const float* xr = out + (size_t)(brow + wr * 64 + fr) * DM;
#pragma unroll
              for (int bj = 0; bj < 2; ++bj)
#pragma unroll
                  for (int n = 0; n < 2; ++n) xv[0][bj][n] = *reinterpret_cast<const f32x4*>(xr + bcol + bj * 128 + n * 16 + cl); }
#pragma unroll
            for (int it = 0; it < 8; ++it) {
                const int ai = it >> 2, m = it & 3;
                if (it + 1 < 8) {
                    const float* xr = out + (size_t)(brow + ((it + 1) >> 2) * 128 + wr * 64 + ((it + 1) & 3) * 16 + fr) * DM;
#pragma unroll
                    for (int bj = 0; bj < 2; ++bj)
#pragma unroll
                        for (int n = 0; n < 2; ++n) xv[(it + 1) & 1][bj][n] = *reinterpret_cast<const f32x4*>(xr + bcol + bj * 128 + n * 16 + cl);
                }
                const int row = brow + ai * 128 + wr * 64 + m * 16 + fr;
#pragma unroll
                for (int bj = 0; bj < 2; ++bj)
#pragma unroll
                    for (int n = 0; n < 2; ++n)
                        *reinterpret_cast<f32x4*>(out + (size_t)row * DM + bcol + bj * 128 + n * 16 + cl) = xv[it & 1][bj][n] * ALPHA + gv[bj][n] * acc[ai][bj][m][n];
                asm volatile("" ::: "memory");
            }
        }
    }
    SEAM(10);

    if (IN(11)) {
        const float* l2g = p.in[21]; const float* l2b = p.in[22];
        constexpr int NR = 4;
        for (int t0 = bx * 8 + wv; t0 < T; t0 += NR * G * 8) {
            f32x4 v[NR][4];
#pragma unroll
            for (int rr = 0; rr < NR; ++rr) {
                const int t = t0 + rr * G * 8; const float* orow = out + (size_t)(t < T ? t : t0) * DM;
#pragma unroll
                for (int c = 0; c < 4; ++c) v[rr][c] = *reinterpret_cast<const f32x4*>(orow + c * 256 + lane * 4);
            }
#pragma unroll
            for (int rr = 0; rr < NR; ++rr) {
                const int t = t0 + rr * G * 8;
                float* orow = out + (size_t)t * DM;
                float s = 0.f;
#pragma unroll
                for (int c = 0; c < 4; ++c) s += (v[rr][c][0] + v[rr][c][1]) + (v[rr][c][2] + v[rr][c][3]);
                const float mean = wave_sum(s) * (1.0f / 1024.0f);
                float q = 0.f;
#pragma unroll
                for (int c = 0; c < 4; ++c) { v[rr][c] = v[rr][c] - mean; q += (v[rr][c][0] * v[rr][c][0] + v[rr][c][1] * v[rr][c][1]) + (v[rr][c][2] * v[rr][c][2] + v[rr][c][3] * v[rr][c][3]); }
                const float rstd = rsqrtf(wave_sum(q) * (1.0f / 1024.0f) + EPS);
                if (t < T) {
#pragma unroll
                    for (int c = 0; c < 4; ++c) {
                        const int col = c * 256 + lane * 4;
                        *reinterpret_cast<f32x4*>(orow + col) = v[rr][c] * rstd * *reinterpret_cast<const f32x4*>(l2g + col) + *reinterpret_cast<const f32x4*>(l2b + col);
                    }
                }
            }
        }
    }
#undef IN
#undef SEAM
}

extern "C" void kernel_launch(void* const* d_in, const int* in_sizes, int n_in, void* d_out, int out_size, void* d_ws, size_t ws_size, hipStream_t stream) {
    static int grid_blocks = 0;
    if (grid_blocks == 0) {
        if (n_in != 23 || out_size != T * DM || ws_size < WS_END) { fprintf(stderr, "kernel_launch: unexpected shapes (n_in %d out %d ws %zu)\n", n_in, out_size, ws_size); grid_blocks = -1; return; }
        int dev = 0, cus = 0, per_cu = 0;
        hipGetDevice(&dev);
        hipDeviceGetAttribute(&cus, hipDeviceAttributeMultiprocessorCount, dev);
        if (hipFuncSetAttribute((const void*)fwd_kernel, hipFuncAttributeMaxDynamicSharedMemorySize, LDS_BYTES) != hipSuccess) { fprintf(stderr, "kernel_launch: hipFuncSetAttribute failed\n"); grid_blocks = -1; return; }
        if (hipOccupancyMaxActiveBlocksPerMultiprocessor(&per_cu, (const void*)fwd_kernel, 512, LDS_BYTES) != hipSuccess || per_cu < 1) { fprintf(stderr, "kernel_launch: occupancy query says %d\n", per_cu); per_cu = 1; }
        (void)hipGetLastError();
        grid_blocks = cus;
    }
    if (grid_blocks < 0) return;
    if (hipMemsetAsync((char*)d_ws + WS_BAR, 0, XCD_BAR_WORDS * 4, stream) != hipSuccess) { fprintf(stderr, "kernel_launch: hipMemsetAsync failed\n"); return; }
    Params p{};
    for (int i = 0; i < 23; ++i) p.in[i] = (const float*)d_in[i];
    p.out = (float*)d_out; p.ws = (unsigned char*)d_ws; p.lo = 0; p.hi = NPHASE;
    void* args[] = {&p};
    hipError_t e = hipLaunchCooperativeKernel((const void*)fwd_kernel, dim3(grid_blocks), dim3(512), args, LDS_BYTES, stream);
    if (e != hipSuccess) fprintf(stderr, "kernel_launch: cooperative launch failed: %s (grid %d)\n", hipGetErrorString(e), grid_blocks);
}
```

```cpp
#include <hip/hip_runtime.h>
#include <hip/hip_cooperative_groups.h>
#include <cstdio>
#include <cstdint>
namespace cg = cooperative_groups;

typedef unsigned short bf16_t;
typedef short bf16x8 __attribute__((ext_vector_type(8)));
typedef float f32x4 __attribute__((ext_vector_type(4)));
typedef float f32x16 __attribute__((ext_vector_type(16)));
typedef unsigned u32x4 __attribute__((ext_vector_type(4)));
typedef unsigned u32x2 __attribute__((ext_vector_type(2)));
typedef float f32x2_t __attribute__((ext_vector_type(2)));
typedef __bf16 bf16x2_t __attribute__((ext_vector_type(2)));

constexpr int DM = 1024, TP = 8 * 2048, TSMP = 8 * 8192, T = TP + TSMP;
constexpr int HP = 1280;
constexpr int DFF = 2816;
constexpr int NMT = T / 256;
constexpr float EPS = 1e-6f;
constexpr float ALPHA = 1.189207115002721f;
constexpr float LOG2E = 1.4426950408889634f;
constexpr float C2A = 0.125f * LOG2E;
constexpr float C2M = 0.10206207261596575f * LOG2E;

constexpr size_t MiB = 1u << 20;
constexpr size_t WS_W1T = 0;
constexpr size_t WS_WUQT = 3 * MiB;
constexpr size_t WS_WUKVT = 4 * MiB;
constexpr size_t WS_WOUTT = 5 * MiB;
constexpr size_t WS_WGUT = 7 * MiB;
constexpr size_t WS_WDNT = 18 * MiB;
constexpr size_t WS_MOD = 24 * MiB;
constexpr size_t WS_COSA = 25 * MiB;
constexpr size_t WS_SINA = 26 * MiB;
constexpr size_t WS_COSB = 27 * MiB;
constexpr size_t WS_SINB = 28 * MiB;
constexpr size_t WS_RSQ = 29 * MiB;
constexpr size_t WS_RSKV = 30 * MiB;
constexpr size_t WS_BAR = 31 * MiB;
constexpr size_t WS_U = 32 * MiB;
constexpr size_t WS_H = 192 * MiB;
constexpr size_t WS_O = 192 * MiB;
constexpr size_t WS_QA = 392 * MiB;
constexpr size_t WS_KA = 472 * MiB;
constexpr size_t WS_VTA = 492 * MiB;
constexpr size_t WS_QM = 512 * MiB;
constexpr size_t WS_KN = 632 * MiB;
constexpr size_t WS_KPE = 712 * MiB;
constexpr size_t WS_VTM = 717 * MiB;
constexpr size_t WS_F = 192 * MiB;
constexpr size_t WS_PQ = 800 * MiB;
constexpr size_t WS_PKV = 802 * MiB;
constexpr size_t WS_END = 804 * MiB;

constexpr int LDS_XST = 147456;
constexpr int LDS_BYTES = LDS_XST + 256;
constexpr int NPHASE = 12;

struct Params {
    const float* in[23];
    float* out;
    unsigned char* ws;
    int lo, hi;
};

__device__ __forceinline__ unsigned cvtpk(float lo, float hi) { f32x2_t v = {lo, hi}; bf16x2_t b = __builtin_convertvector(v, bf16x2_t); return __builtin_bit_cast(unsigned, b); }
__device__ __forceinline__ bf16_t f2bf(float f) { return (bf16_t)(cvtpk(f, 0.f) & 0xffffu); }
__device__ __forceinline__ float bf2f(unsigned short h) { return __uint_as_float(((unsigned)h) << 16); }
__device__ __forceinline__ float wave_sum(float v) {
#pragma unroll
    for (int o = 32; o >= 1; o >>= 1) v += __shfl_xor(v, o);
    return v;
}
__device__ __forceinline__ void tokinfo(int t, int& b, int& S, int& tok0) {
    if (t < TP) { b = t >> 11; S = 2048; tok0 = b << 11; }
    else { const int u = t - TP; const int bb = u >> 13; b = 8 + bb; S = 8192; tok0 = TP + (bb << 13); }
}
__device__ __forceinline__ const float* xrow(const float* xp, const float* xs, int t) {
    return t < TP ? xp + (size_t)t * DM : xs + (size_t)(t - TP) * DM;
}

constexpr int HTB = 128 * 64 * 2;
__device__ __forceinline__ int lds_byte(int r, int c) {
    const int st = (r >> 4) * 2 + (c >> 5), rr = r & 15, cc = c & 31, ob = rr * 64 + cc * 2;
    return st * 1024 + (ob ^ (((ob >> 9) & 1) << 5));
}
__device__ __forceinline__ void stage_rc(int b, int& R, int& C) {
    const int st = b / 1024, sb = b % 1024, swz = sb ^ (((sb >> 9) & 1) << 5);
    R = (st >> 1) * 16 + swz / 64; C = (st & 1) * 32 + (swz % 64) / 2;
}
__device__ __forceinline__ bool tile_next(int i, int G, int c, int nM, int nN, int& pm, int& pn) {
    const int nwg = nM * nN; const long L = (long)i * G + c; if (L >= nwg) return false;
    int wgid = (int)L;
    if ((G & 7) == 0) { const int q = nwg / 8, r = nwg % 8, xcd = wgid % 8, off = wgid / 8; wgid = (xcd < r ? xcd * (q + 1) : r * (q + 1) + (xcd - r) * q) + off; }
    const int nig = 8 * nN, gid = wgid / nig, fm = gid * 8, gsz = (nM - fm) < 8 ? (nM - fm) : 8;
    pm = fm + ((wgid % nig) % gsz); pn = (wgid % nig) / gsz; return true;
}

#define WAIT_V(n) asm volatile("s_waitcnt vmcnt(" #n ")" ::: "memory")
#define WAIT_L(n) asm volatile("s_waitcnt lgkmcnt(" #n ")" ::: "memory")
#define BAR __builtin_amdgcn_s_barrier()
#define SCHED __builtin_amdgcn_sched_barrier(0)

__device__ __forceinline__ void glds16(const void* sbase, unsigned voff, unsigned ldsdst) {
    unsigned keep;
    asm volatile("s_mov_b32 %0, m0\n\ts_mov_b32 m0, %3\n\ts_nop 0\n\tglobal_load_lds_dwordx4 %2, %1\n\ts_mov_b32 m0, %0"
                 : "=&s"(keep) : "s"(sbase), "v"(voff), "s"(ldsdst) : "memory");
}
template <bool TR>
__device__ __forceinline__ void gemm_core(unsigned char* shm, const bf16_t* __restrict__ A, int lda, const bf16_t* __restrict__ Bt, int ldb,
                                          int nt, int brow, int bcol, f32x4 (&acc)[2][2][4][2]) {
    const int wid = threadIdx.x >> 6, lane = threadIdx.x & 63, wr = wid >> 2, wc = wid & 3, fr = lane & 15, fq = lane >> 4;
    int sr0, sc0; stage_rc(threadIdx.x * 16, sr0, sc0);
    const unsigned offA = (unsigned)(sr0 * lda + sc0) * 2u, offB = (unsigned)(sr0 * ldb + sc0) * 2u;
    const unsigned ldsw = (unsigned)(uintptr_t)shm + (unsigned)__builtin_amdgcn_readfirstlane(wid) * 1024u;
#define SA(b, h) (shm + ((b) * 2 + (h)) * HTB)
#define SB(b, h) (shm + (4 + (b) * 2 + (h)) * HTB)
#define SAO(b, h) (((b) * 2 + (h)) * HTB)
#define SBO(b, h) ((4 + (b) * 2 + (h)) * HTB)
#define STAGE(PO, BASE, LD, VO, br, kt) do { \
        const char* b0_ = (const char*)(BASE) + ((long)(br) * (LD) + (long)(kt) * 64) * 2; \
        glds16(b0_, VO, ldsw + (PO)); glds16(b0_ + (long)(LD) * 128, VO, ldsw + (PO) + 8192u); } while (0)
#define LDA(dst, b, h) for (int m = 0; m < 4; ++m) for (int k = 0; k < 2; ++k) \
        dst[m][k] = *reinterpret_cast<const bf16x8*>(SA(b, h) + lds_byte(wr * 64 + m * 16 + fr, k * 32 + fq * 8))
#define LDB(dst, b, h) for (int n = 0; n < 2; ++n) for (int k = 0; k < 2; ++k) \
        dst[n][k] = *reinterpret_cast<const bf16x8*>(SB(b, h) + lds_byte(wc * 32 + n * 16 + fr, k * 32 + fq * 8))
#define MMA(ai, bj, At_, Bt_) do { __builtin_amdgcn_s_setprio(1); \
        for (int m = 0; m < 4; ++m) for (int n = 0; n < 2; ++n) for (int k = 0; k < 2; ++k) \
            acc[ai][bj][m][n] = TR ? __builtin_amdgcn_mfma_f32_16x16x32_bf16(Bt_[n][k], At_[m][k], acc[ai][bj][m][n], 0, 0, 0) \
                                   : __builtin_amdgcn_mfma_f32_16x16x32_bf16(At_[m][k], Bt_[n][k], acc[ai][bj][m][n], 0, 0, 0); \
        __builtin_amdgcn_s_setprio(0); } while (0)
    bf16x8 At[4][2], B0[2][2], B1[2][2];
#pragma unroll
    for (int a = 0; a < 2; ++a)
#pragma unroll
        for (int b = 0; b < 2; ++b)
#pragma unroll
            for (int m = 0; m < 4; ++m)
#pragma unroll
                for (int n = 0; n < 2; ++n) acc[a][b][m][n] = (f32x4){0.f, 0.f, 0.f, 0.f};
    STAGE(SBO(0, 0), Bt, ldb, offB, bcol, 0); STAGE(SAO(0, 0), A, lda, offA, brow, 0);
    STAGE(SBO(0, 1), Bt, ldb, offB, bcol + 128, 0); STAGE(SAO(0, 1), A, lda, offA, brow + 128, 0);
    if (wr == 1) BAR;
    WAIT_V(4); BAR;
    STAGE(SBO(1, 0), Bt, ldb, offB, bcol, 1); STAGE(SAO(1, 0), A, lda, offA, brow, 1); STAGE(SBO(1, 1), Bt, ldb, offB, bcol + 128, 1);
    WAIT_V(6); BAR;
    for (int t = 0; t < nt - 2; t += 2) {
        LDB(B0, 0, 0); SCHED; LDA(At, 0, 0); STAGE(SAO(1, 1), A, lda, offA, brow + 128, t + 1);
        WAIT_L(8); BAR; WAIT_L(0); MMA(0, 0, At, B0); BAR; SCHED;
        LDB(B1, 0, 1); STAGE(SBO(0, 0), Bt, ldb, offB, bcol, t + 2);
        BAR; WAIT_L(0); MMA(0, 1, At, B1); BAR;
        LDA(At, 0, 1); STAGE(SAO(0, 0), A, lda, offA, brow, t + 2);
        BAR; WAIT_L(0); MMA(1, 0, At, B0); BAR; SCHED;
        STAGE(SBO(0, 1), Bt, ldb, offB, bcol + 128, t + 2);
        WAIT_V(6); BAR; MMA(1, 1, At, B1); BAR;
        LDB(B0, 1, 0); SCHED; LDA(At, 1, 0); STAGE(SAO(0, 1), A, lda, offA, brow + 128, t + 2);
        WAIT_L(8); BAR; WAIT_L(0); MMA(0, 0, At, B0); BAR; SCHED;
        LDB(B1, 1, 1); STAGE(SBO(1, 0), Bt, ldb, offB, bcol, t + 3);
        BAR; WAIT_L(0); MMA(0, 1, At, B1); BAR;
        LDA(At, 1, 1); STAGE(SAO(1, 0), A, lda, offA, brow, t + 3);
        BAR; WAIT_L(0); MMA(1, 0, At, B0); BAR; SCHED;
        STAGE(SBO(1, 1), Bt, ldb, offB, bcol + 128, t + 3);
        WAIT_V(6); BAR; MMA(1, 1, At, B1); BAR;
    }
    { LDB(B0, 0, 0); LDA(At, 0, 0); STAGE(SAO(1, 1), A, lda, offA, brow + 128, nt - 1);
      BAR; WAIT_L(0); MMA(0, 0, At, B0); BAR;
      LDB(B1, 0, 1); BAR; WAIT_L(0); MMA(0, 1, At, B1); BAR;
      LDA(At, 0, 1); WAIT_V(4); BAR; WAIT_L(0); MMA(1, 0, At, B0); MMA(1, 1, At, B1); BAR; }
    { LDB(B0, 1, 0); LDA(At, 1, 0); WAIT_V(2); BAR; WAIT_L(0); MMA(0, 0, At, B0); BAR;
      LDB(B1, 1, 1); WAIT_V(0); BAR; WAIT_L(0); MMA(0, 1, At, B1); BAR;
      LDA(At, 1, 1); BAR; WAIT_L(0); MMA(1, 0, At, B0); MMA(1, 1, At, B1); BAR; }
    if (wr == 0) BAR;
#undef SA
#undef SB
#undef SAO
#undef SBO
#undef STAGE
#undef LDA
#undef LDB
#undef MMA
}

#define EPI_GEOM int tid_e = threadIdx.x; asm volatile("" : "+v"(tid_e)); const int wid = tid_e >> 6, lane = tid_e & 63, wr = wid >> 2, wc = wid & 3, fr = lane & 15, fq = lane >> 4; (void)wr; (void)wc; (void)fr; (void)fq;

__device__ __forceinline__ float dot2ones(unsigned pk, float acc) {
    return __builtin_amdgcn_fdot2_f32_bf16(__builtin_bit_cast(bf16x2_t, pk), __builtin_bit_cast(bf16x2_t, 0x3F803F80u), acc, false);
}
__device__ __forceinline__ int kperm(int i) { return (i & ~12) | ((i & 4) << 1) | ((i & 8) >> 1); }

__device__ __forceinline__ float xmax(float v) {
    auto rr = __builtin_amdgcn_permlane32_swap(__float_as_uint(v), __float_as_uint(v), false, false);
    return fmaxf(__uint_as_float(rr[0]), __uint_as_float(rr[1]));
}
__device__ __forceinline__ float xsum(float v) {
    auto rr = __builtin_amdgcn_permlane32_swap(__float_as_uint(v), __float_as_uint(v), false, false);
    return __uint_as_float(rr[0]) + __uint_as_float(rr[1]);
}
template <int DQ>
__device__ __forceinline__ void attn_unit2(unsigned char* shm, const bf16_t* __restrict__ Q0, const bf16_t* __restrict__ Q1, int ldq,
                                           const bf16_t* __restrict__ K1, int ldk1, const bf16_t* __restrict__ K2, const bf16_t* __restrict__ Vt, int S,
                                           bf16_t* __restrict__ O0, bf16_t* __restrict__ O1) {
    constexpr int KP = DQ * 2 + 16, VP = 144, VOFF = 64 * KP, BUFB = VOFF + 64 * VP, ND0 = DQ / 16;
    constexpr float THR = 6.0f;
    const int tid = threadIdx.x, lane = tid & 63, wid = tid >> 6, r32 = lane & 31, hi = lane >> 5;
    const int skey = tid >> 3, sch = tid & 7;
    const int pkey = tid >> 2, pch = tid & 3;
    const bf16_t* kg = K1 + (size_t)skey * ldk1 + sch * 8;
    const bf16_t* pg = (DQ == 96) ? (K2 + (size_t)pkey * 32 + pch * 8) : nullptr;
    const bf16_t* vg = Vt + (size_t)skey * S + sch * 8;
    const int kst = skey * KP + sch * 16, pst = pkey * KP + 128 + pch * 16, vst = VOFF + skey * VP + sch * 16;
    const int qlo = 49152 + wid * (2 * 6 * 1024) + lane * 16;
    { const bf16_t* qp0 = Q0 + (size_t)(wid * 32 + r32) * ldq + hi * 8; const bf16_t* qp1 = Q1 + (size_t)(wid * 32 + r32) * ldq + hi * 8;
      {
#pragma unroll
          for (int d0 = 0; d0 < ND0; ++d0) {
              *reinterpret_cast<bf16x8*>(shm + qlo + d0 * 1024) = *reinterpret_cast<const bf16x8*>(qp0 + d0 * 16);
              *reinterpret_cast<bf16x8*>(shm + qlo + (6 + d0) * 1024) = *reinterpret_cast<const bf16x8*>(qp1 + d0 * 16);
          }
      } }
    const int kfo = kperm(r32) * KP + hi * 16;
    const int vfo = VOFF + r32 * VP + hi * 16;
    const int NT = S / 64;
    u32x4 kreg, preg, vreg;
    kreg = *reinterpret_cast<const u32x4*>(kg); vreg = *reinterpret_cast<const u32x4*>(vg);
    if (DQ == 96) { if (tid < 256) preg = *reinterpret_cast<const u32x4*>(pg); }
    __syncthreads();
    *reinterpret_cast<u32x4*>(shm + kst) = kreg; *reinterpret_cast<u32x4*>(shm + vst) = vreg;
    if (DQ == 96) { if (tid < 256) *reinterpret_cast<u32x4*>(shm + pst) = preg; }
    __syncthreads();
    float m_run[2] = {0.f, 0.f}, l_run[2] = {0.f, 0.f};
    f32x16 zc;
#pragma unroll
    for (int r = 0; r < 16; ++r) zc[r] = 0.f;
    f32x16 o[2][2];
#pragma unroll
    for (int sb = 0; sb < 2; ++sb)
#pragma unroll
        for (int r = 0; r < 16; ++r) { o[sb][0][r] = 0.f; o[sb][1][r] = 0.f; }
    for (int t = 0; t < NT; ++t) {
        const unsigned char* buf = shm + (t & 1) * BUFB;
        if (t + 1 < NT) {
            kreg = *reinterpret_cast<const u32x4*>(kg + (size_t)(t + 1) * 64 * ldk1);
            vreg = *reinterpret_cast<const u32x4*>(vg + (t + 1) * 64);
            if (DQ == 96) { if (tid < 256) preg = *reinterpret_cast<const u32x4*>(pg + (size_t)(t + 1) * 64 * 32); }
        }
        const bool first = (t == 0);
        if (DQ == 64) {
            f32x16 p[2][2];
#pragma unroll
            for (int h = 0; h < 2; ++h) {
                bf16x8 kf[4], qa[2], qb[2];
#pragma unroll
                for (int dd = 0; dd < 2; ++dd) {
                    kf[2 * dd] = *reinterpret_cast<const bf16x8*>(buf + kfo + (2 * h + dd) * 32);
                    kf[2 * dd + 1] = *reinterpret_cast<const bf16x8*>(buf + kfo + 32 * KP + (2 * h + dd) * 32);
                    qa[dd] = *reinterpret_cast<const bf16x8*>(shm + qlo + (2 * h + dd) * 1024);
                    qb[dd] = *reinterpret_cast<const bf16x8*>(shm + qlo + (6 + 2 * h + dd) * 1024);
                }
                __builtin_amdgcn_sched_barrier(0);
                if (h == 0) {
                    p[0][0] = __builtin_amdgcn_mfma_f32_32x32x16_bf16(kf[0], qa[0], zc, 0, 0, 0);
                    p[0][1] = __builtin_amdgcn_mfma_f32_32x32x16_bf16(kf[1], qa[0], zc, 0, 0, 0);
                    p[1][0] = __builtin_amdgcn_mfma_f32_32x32x16_bf16(kf[0], qb[0], zc, 0, 0, 0);
                    p[1][1] = __builtin_amdgcn_mfma_f32_32x32x16_bf16(kf[1], qb[0], zc, 0, 0, 0);
                } else {
                    p[0][0] = __builtin_amdgcn_mfma_f32_32x32x16_bf16(kf[0], qa[0], p[0][0], 0, 0, 0);
                    p[0][1] = __builtin_amdgcn_mfma_f32_32x32x16_bf16(kf[1], qa[0], p[0][1], 0, 0, 0);
                    p[1][0] = __builtin_amdgcn_mfma_f32_32x32x16_bf16(kf[0], qb[0], p[1][0], 0, 0, 0);
                    p[1][1] = __builtin_amdgcn_mfma_f32_32x32x16_bf16(kf[1], qb[0], p[1][1], 0, 0, 0);
                }
                p[0][0] = __builtin_amdgcn_mfma_f32_32x32x16_bf16(kf[2], qa[1], p[0][0], 0, 0, 0);
                p[0][1] = __builtin_amdgcn_mfma_f32_32x32x16_bf16(kf[3], qa[1], p[0][1], 0, 0, 0);
                p[1][0] = __builtin_amdgcn_mfma_f32_32x32x16_bf16(kf[2], qb[1], p[1][0], 0, 0, 0);
                p[1][1] = __builtin_amdgcn_mfma_f32_32x32x16_bf16(kf[3], qb[1], p[1][1], 0, 0, 0);
                __builtin_amdgcn_sched_barrier(0);
            }
            bf16x8 vf[8];
#pragma unroll
            for (int ks = 0; ks < 4; ++ks) {
                vf[2 * ks] = *reinterpret_cast<const bf16x8*>(buf + vfo + ks * 32);
                vf[2 * ks + 1] = *reinterpret_cast<const bf16x8*>(buf + vfo + 32 * VP + ks * 32);
            }
            __builtin_amdgcn_sched_barrier(0);
            float rm[2];
#pragma unroll
            for (int sb = 0; sb < 2; ++sb) {
                const f32x16& p0 = p[sb][0]; const f32x16& p1 = p[sb][1];
                float a0 = __builtin_fmaxf(__builtin_fmaxf(p0[0], p0[1]), p1[0]), a1 = __builtin_fmaxf(__builtin_fmaxf(p0[2], p0[3]), p1[1]);
                a0 = __builtin_fmaxf(__builtin_fmaxf(a0, p1[2]), p1[3]);
#pragma unroll
                for (int r = 4; r < 16; r += 4) {
                    a0 = __builtin_fmaxf(__builtin_fmaxf(a0, p0[r]), p0[r + 1]); a1 = __builtin_fmaxf(__builtin_fmaxf(a1, p0[r + 2]), p0[r + 3]);
                    a0 = __builtin_fmaxf(__builtin_fmaxf(a0, p1[r]), p1[r + 1]); a1 = __builtin_fmaxf(__builtin_fmaxf(a1, p1[r + 2]), p1[r + 3]);
                }
                rm[sb] = xmax(__builtin_fmaxf(a0, a1));
            }
            {   const float rmc = fmaxf(rm[0], rm[1]);
                if (first || __any(rmc > THR)) {
                    const float dl = first ? rmc : fmaxf(rmc, 0.f);
                    const float al = first ? 0.f : __builtin_amdgcn_exp2f(-dl);
                    m_run[0] += dl; l_run[0] *= al; l_run[1] *= al;
#pragma unroll
                    for (int r = 0; r < 16; ++r) { zc[r] -= dl;
                        o[0][0][r] *= al; o[0][1][r] *= al; o[1][0][r] *= al; o[1][1][r] *= al;
                        p[0][0][r] -= dl; p[0][1][r] -= dl; p[1][0][r] -= dl; p[1][1][r] -= dl; }
                }
            }
#define SM_STEP(SB, PW) do { f32x16& p0 = p[SB][0]; f32x16& p1 = p[SB][1]; float ls0 = 0.f, ls1 = 0.f; \
                _Pragma("unroll") for (int r = 0; r < 16; ++r) { p0[r] = __builtin_amdgcn_exp2f(p0[r]); p1[r] = __builtin_amdgcn_exp2f(p1[r]); } \
                PW[0] = (u32x4){cvtpk(p0[0], p0[1]), cvtpk(p0[2], p0[3]), cvtpk(p0[4], p0[5]), cvtpk(p0[6], p0[7])}; \
                PW[1] = (u32x4){cvtpk(p0[8], p0[9]), cvtpk(p0[10], p0[11]), cvtpk(p0[12], p0[13]), cvtpk(p0[14], p0[15])}; \
                PW[2] = (u32x4){cvtpk(p1[0], p1[1]), cvtpk(p1[2], p1[3]), cvtpk(p1[4], p1[5]), cvtpk(p1[6], p1[7])}; \
                PW[3] = (u32x4){cvtpk(p1[8], p1[9]), cvtpk(p1[10], p1[11]), cvtpk(p1[12], p1[13]), cvtpk(p1[14], p1[15])}; \
                _Pragma("unroll") for (int k = 0; k < 4; ++k) { ls0 = dot2ones(PW[k][0], ls0); ls1 = dot2ones(PW[k][1], ls1); ls0 = dot2ones(PW[k][2], ls0); ls1 = dot2ones(PW[k][3], ls1); } \
                l_run[SB] += ls0 + ls1; } while (0)
            u32x4 pwa[4], pwb[4];
            SM_STEP(0, pwa);
            __builtin_amdgcn_sched_barrier(0);
#pragma unroll
            for (int ks = 0; ks < 4; ++ks) {
                const bf16x8 pb = __builtin_bit_cast(bf16x8, pwa[ks]);
                o[0][0] = __builtin_amdgcn_mfma_f32_32x32x16_bf16(vf[2 * ks], pb, o[0][0], 0, 0, 0);
                o[0][1] = __builtin_amdgcn_mfma_f32_32x32x16_bf16(vf[2 * ks + 1], pb, o[0][1], 0, 0, 0);
            }
            SM_STEP(1, pwb);
#pragma unroll
            for (int g = 0; g < 8; ++g) { __builtin_amdgcn_sched_group_barrier(0x008, 1, 0); __builtin_amdgcn_sched_group_barrier(0x002 | 0x400, 14, 0); }
            __builtin_amdgcn_sched_barrier(0);
#undef SM_STEP
#pragma unroll
            for (int ks = 0; ks < 4; ++ks) {
                const bf16x8 pb = __builtin_bit_cast(bf16x8, pwb[ks]);
                o[1][0] = __builtin_amdgcn_mfma_f32_32x32x16_bf16(vf[2 * ks], pb, o[1][0], 0, 0, 0);
                o[1][1] = __builtin_amdgcn_mfma_f32_32x32x16_bf16(vf[2 * ks + 1], pb, o[1][1], 0, 0, 0);
            }
            __builtin_amdgcn_sched_barrier(0);
        } else {
#define QK_STEP(SB, P0, P1) do { \
            _Pragma("unroll") for (int kh = 0; kh < 2; ++kh) { \
                bf16x8 kf[6]; \
                _Pragma("unroll") for (int dd = 0; dd < 3; ++dd) { \
                    kf[2 * dd] = *reinterpret_cast<const bf16x8*>(buf + kfo + (kh * 3 + dd) * 32); \
                    kf[2 * dd + 1] = *reinterpret_cast<const bf16x8*>(buf + kfo + 32 * KP + (kh * 3 + dd) * 32); } \
                __builtin_amdgcn_sched_barrier(0); \
                _Pragma("unroll") for (int dd = 0; dd < 3; ++dd) { \
                    const bf16x8 qf = *reinterpret_cast<const bf16x8*>(shm + qlo + ((SB) * 6 + kh * 3 + dd) * 1024); \
                    if (kh == 0 && dd == 0) { \
                        P0 = __builtin_amdgcn_mfma_f32_32x32x16_bf16(kf[0], qf, zc, 0, 0, 0); P1 = __builtin_amdgcn_mfma_f32_32x32x16_bf16(kf[1], qf, zc, 0, 0, 0); } \
                    else { P0 = __builtin_amdgcn_mfma_f32_32x32x16_bf16(kf[2 * dd], qf, P0, 0, 0, 0); P1 = __builtin_amdgcn_mfma_f32_32x32x16_bf16(kf[2 * dd + 1], qf, P1, 0, 0, 0); } } \
                __builtin_amdgcn_sched_barrier(0); } } while (0)
#define ROWMAX_S(P0, P1, RM) do { \
            float a0 = __builtin_fmaxf(__builtin_fmaxf(P0[0], P0[1]), P1[0]), a1 = __builtin_fmaxf(__builtin_fmaxf(P0[2], P0[3]), P1[1]); \
            a0 = __builtin_fmaxf(__builtin_fmaxf(a0, P1[2]), P1[3]); \
            _Pragma("unroll") for (int r = 4; r < 16; r += 4) { \
                a0 = __builtin_fmaxf(__builtin_fmaxf(a0, P0[r]), P0[r + 1]); a1 = __builtin_fmaxf(__builtin_fmaxf(a1, P0[r + 2]), P0[r + 3]); \
                a0 = __builtin_fmaxf(__builtin_fmaxf(a0, P1[r]), P1[r + 1]); a1 = __builtin_fmaxf(__builtin_fmaxf(a1, P1[r + 2]), P1[r + 3]); } \
            RM = xmax(__builtin_fmaxf(a0, a1));   } while (0)
#define SM_STEP(SB, P0, P1, PW) do { float ls0 = 0.f, ls1 = 0.f; \
            _Pragma("unroll") for (int r = 0; r < 16; ++r) { P0[r] = __builtin_amdgcn_exp2f(P0[r]); P1[r] = __builtin_amdgcn_exp2f(P1[r]); } \
            PW[0] = (u32x4){cvtpk(P0[0], P0[1]), cvtpk(P0[2], P0[3]), cvtpk(P0[4], P0[5]), cvtpk(P0[6], P0[7])}; \
            PW[1] = (u32x4){cvtpk(P0[8], P0[9]), cvtpk(P0[10], P0[11]), cvtpk(P0[12], P0[13]), cvtpk(P0[14], P0[15])}; \
            PW[2] = (u32x4){cvtpk(P1[0], P1[1]), cvtpk(P1[2], P1[3]), cvtpk(P1[4], P1[5]), cvtpk(P1[6], P1[7])}; \
            PW[3] = (u32x4){cvtpk(P1[8], P1[9]), cvtpk(P1[10], P1[11]), cvtpk(P1[12], P1[13]), cvtpk(P1[14], P1[15])}; \
            _Pragma("unroll") for (int k = 0; k < 4; ++k) { ls0 = dot2ones(PW[k][0], ls0); ls1 = dot2ones(PW[k][1], ls1); ls0 = dot2ones(PW[k][2], ls0); ls1 = dot2ones(PW[k][3], ls1); } \
            l_run[SB] += ls0 + ls1; } while (0)
            u32x4 pwa[4], pwb[4];
            f32x16 pa0, pa1, pb0, pb1;
#pragma unroll
            for (int kh = 0; kh < 2; ++kh) {
                bf16x8 kf[6], qa[3], qb[3];
#pragma unroll
                for (int dd = 0; dd < 3; ++dd) {
                    kf[2 * dd] = *reinterpret_cast<const bf16x8*>(buf + kfo + (kh * 3 + dd) * 32);
                    kf[2 * dd + 1] = *reinterpret_cast<const bf16x8*>(buf + kfo + 32 * KP + (kh * 3 + dd) * 32);
                    qa[dd] = *reinterpret_cast<const bf16x8*>(shm + qlo + (kh * 3 + dd) * 1024);
                    qb[dd] = *reinterpret_cast<const bf16x8*>(shm + qlo + (6 + kh * 3 + dd) * 1024);
                }
                __builtin_amdgcn_sched_barrier(0);
#pragma unroll
                for (int dd = 0; dd < 3; ++dd) {
                    if (kh == 0 && dd == 0) {
                        pa0 = __builtin_amdgcn_mfma_f32_32x32x16_bf16(kf[0], qa[0], zc, 0, 0, 0); pa1 = __builtin_amdgcn_mfma_f32_32x32x16_bf16(kf[1], qa[0], zc, 0, 0, 0);
                        pb0 = __builtin_amdgcn_mfma_f32_32x32x16_bf16(kf[0], qb[0], zc, 0, 0, 0); pb1 = __builtin_amdgcn_mfma_f32_32x32x16_bf16(kf[1], qb[0], zc, 0, 0, 0);
                    } else {
                        pa0 = __builtin_amdgcn_mfma_f32_32x32x16_bf16(kf[2 * dd], qa[dd], pa0, 0, 0, 0); pa1 = __builtin_amdgcn_mfma_f32_32x32x16_bf16(kf[2 * dd + 1], qa[dd], pa1, 0, 0, 0);
                        pb0 = __builtin_amdgcn_mfma_f32_32x32x16_bf16(kf[2 * dd], qb[dd], pb0, 0, 0, 0); pb1 = __builtin_amdgcn_mfma_f32_32x32x16_bf16(kf[2 * dd + 1], qb[dd], pb1, 0, 0, 0);
                    }
                }
                __builtin_amdgcn_sched_barrier(0);
            }
            bf16x8 vf[8];
#pragma unroll
            for (int ks = 0; ks < 4; ++ks) {
                vf[2 * ks] = *reinterpret_cast<const bf16x8*>(buf + vfo + ks * 32);
                vf[2 * ks + 1] = *reinterpret_cast<const bf16x8*>(buf + vfo + 32 * VP + ks * 32);
            }
            {
                float rma, rmb; ROWMAX_S(pa0, pa1, rma); ROWMAX_S(pb0, pb1, rmb);
                const float rmc = fmaxf(rma, rmb);
                if (first || __any(rmc > THR)) {
                    const float dl = first ? rmc : fmaxf(rmc, 0.f); const float al = first ? 0.f : __builtin_amdgcn_exp2f(-dl);
                    m_run[0] += dl; l_run[0] *= al; l_run[1] *= al;
#pragma unroll
                    for (int r = 0; r < 16; ++r) { zc[r] -= dl; o[0][0][r] *= al; o[0][1][r] *= al; o[1][0][r] *= al; o[1][1][r] *= al;
                        pa0[r] -= dl; pa1[r] -= dl; pb0[r] -= dl; pb1[r] -= dl; }
                }
            }
            SM_STEP(0, pa0, pa1, pwa);
            __builtin_amdgcn_sched_barrier(0);
#pragma unroll
            for (int ks = 0; ks < 4; ++ks) {
                const bf16x8 pb = __builtin_bit_cast(bf16x8, pwa[ks]);
                o[0][0] = __builtin_amdgcn_mfma_f32_32x32x16_bf16(vf[2 * ks], pb, o[0][0], 0, 0, 0);
                o[0][1] = __builtin_amdgcn_mfma_f32_32x32x16_bf16(vf[2 * ks + 1], pb, o[0][1], 0, 0, 0);
            }
            SM_STEP(1, pb0, pb1, pwb);
#pragma unroll
            for (int g = 0; g < 8; ++g) { __builtin_amdgcn_sched_group_barrier(0x008, 1, 0); __builtin_amdgcn_sched_group_barrier(0x002 | 0x400, 14, 0); }
            __builtin_amdgcn_sched_barrier(0);
#undef QK_STEP
#undef ROWMAX_S
#undef SM_STEP
#pragma unroll
            for (int ks = 0; ks < 4; ++ks) {
                const bf16x8 pb = __builtin_bit_cast(bf16x8, pwb[ks]);
                o[1][0] = __builtin_amdgcn_mfma_f32_32x32x16_bf16(vf[2 * ks], pb, o[1][0], 0, 0, 0);
                o[1][1] = __builtin_amdgcn_mfma_f32_32x32x16_bf16(vf[2 * ks + 1], pb, o[1][1], 0, 0, 0);
            }
            __builtin_amdgcn_sched_barrier(0);
        }
        if (t + 1 < NT) {
            unsigned char* nb = shm + ((t + 1) & 1) * BUFB;
            *reinterpret_cast<u32x4*>(nb + kst) = kreg; *reinterpret_cast<u32x4*>(nb + vst) = vreg;
            if (DQ == 96) { if (tid < 256) *reinterpret_cast<u32x4*>(nb + pst) = preg; }
        }
        __syncthreads();
    }
#pragma unroll
    for (int sb = 0; sb < 2; ++sb) {
        const float lt = xsum(l_run[sb]);
        const float inv = 1.0f / lt;
        bf16_t* op = (sb == 0 ? O0 : O1) + (size_t)(wid * 32 + r32) * DM + 4 * hi;
#pragma unroll
        for (int g = 0; g < 4; ++g) {
            *reinterpret_cast<u32x2*>(op + 8 * g) = (u32x2){cvtpk(o[sb][0][4 * g] * inv, o[sb][0][4 * g + 1] * inv), cvtpk(o[sb][0][4 * g + 2] * inv, o[sb][0][4 * g + 3] * inv)};
            *reinterpret_cast<u32x2*>(op + 32 + 8 * g) = (u32x2){cvtpk(o[sb][1][4 * g] * inv, o[sb][1][4 * g + 1] * inv), cvtpk(o[sb][1][4 * g + 2] * inv, o[sb][1][4 * g + 3] * inv)};
        }
    }
}

template <int MODE>
__device__ __forceinline__ void conv_weight(const float* __restrict__ W, int K, int N, bf16_t* __restrict__ dst, int ldb,
                                            const float* __restrict__ gA, const float* __restrict__ gB, int gtid, int gthreads) {
    const int total = N * (K / 8);
    for (int i = gtid; i < total; i += gthreads) {
        const int kq = i / N, n = i - kq * N, k0 = kq * 8;
        float v[8];
#pragma unroll
        for (int j = 0; j < 8; ++j) {
            float w = W[(size_t)(k0 + j) * N + n];
            if (MODE == 1) w *= gA[k0 + j];
            if (MODE == 2) w *= (k0 + j < 512) ? gA[k0 + j] : gB[k0 + j - 512];
            v[j] = w;
        }
        int row = n;
        if (MODE == 3) row = (n >> 7) * 256 + (n & 127);
        if (MODE == 4) row = (n >> 7) * 256 + 128 + (n & 127);
        *reinterpret_cast<u32x4*>(dst + (size_t)row * ldb + k0) = (u32x4){cvtpk(v[0], v[1]), cvtpk(v[2], v[3]), cvtpk(v[4], v[5]), cvtpk(v[6], v[7])};
    }
}

#define LAS __attribute__((address_space(3)))
#define XB_TMO      128
#define XB_XCNT(j)  (256  + 64 * (j))
#define XB_XSUB(j)  (1280 + 64 * (j))
#define XB_XGEN(j)  (2304 + 64 * (j))
#define XB_TOP      3328
#define XB_TOPGEN   3392
#define XCD_BAR_WORDS 3456
#define XB_SPIN_CAP (1u << 18)
__device__ __forceinline__ unsigned xb_ld(unsigned* p)              { return __hip_atomic_load(p, __ATOMIC_RELAXED, __HIP_MEMORY_SCOPE_AGENT); }
__device__ __forceinline__ unsigned xb_add(unsigned* p, unsigned v) { return __hip_atomic_fetch_add(p, v, __ATOMIC_RELAXED, __HIP_MEMORY_SCOPE_AGENT); }
__device__ __forceinline__ unsigned xb_xcc_id() { return (unsigned)__builtin_amdgcn_s_getreg((3 << 11) | 20) & 0xFu; }
#define XB_SPIN(cond, bar) do { unsigned _sp = 0; while (cond) { __builtin_amdgcn_s_sleep(1); \
    if ((++_sp & 255u) == 0u) { if (xb_ld(&(bar)[XB_TMO])) break; if (_sp > XB_SPIN_CAP) { atomicAdd(&(bar)[XB_TMO], 1u); break; } } } } while (0)
__device__ __forceinline__ void xcd_barrier_complete(unsigned* bar, unsigned x, unsigned& nloc, unsigned& nx) {
    const unsigned G = gridDim.x * gridDim.y * gridDim.z;
    unsigned sum, cnt, mine, sp = 0u;
    for (;;) {
        sum = 0u; cnt = 0u; mine = 0u;
#pragma unroll
        for (unsigned j = 0; j < 16; ++j) { const unsigned c = xb_ld(&bar[XB_XCNT(j)]); sum += c; cnt += (c > 0u) ? 1u : 0u; mine = (j == x) ? c : mine; }
        if (sum == G) break;
        __builtin_amdgcn_s_sleep(1);
        if ((++sp & 255u) == 0u) { if (xb_ld(&bar[XB_TMO])) break; if (sp > XB_SPIN_CAP) { atomicAdd(&bar[XB_TMO], 1u); break; } }
    }
    nloc = mine > 0u ? mine : 1u; nx = cnt > 0u ? cnt : 1u;
}
__device__ __forceinline__ void xcd_barrier(unsigned* bar, unsigned x, volatile LAS unsigned* st, bool leader) {
    asm volatile("s_waitcnt vmcnt(0)" ::: "memory");
    __syncthreads();
    if (leader) {
        __builtin_amdgcn_s_waitcnt(0);
        unsigned nloc = st[0], nx = st[1];
        if (nloc == 0u) { xcd_barrier_complete(bar, x, nloc, nx); st[0] = nloc; st[1] = nx; }
        const unsigned old = xb_add(&bar[XB_XSUB(x)], 1u);
        const unsigned gen = old / nloc;
        if (old + 1u == (gen + 1u) * nloc) {
            __builtin_amdgcn_fence(__ATOMIC_RELEASE, "agent");
            asm volatile("s_waitcnt vmcnt(0)" ::: "memory");
            const unsigned og = xb_add(&bar[XB_TOP], 1u);
            const unsigned tg = og / nx;
            if (og + 1u == (tg + 1u) * nx) xb_add(&bar[XB_TOPGEN], 1u);
            else XB_SPIN(xb_ld(&bar[XB_TOPGEN]) == tg, bar);
            __builtin_amdgcn_fence(__ATOMIC_ACQUIRE, "agent");
            xb_add(&bar[XB_XGEN(x)], 1u);
            asm volatile("s_waitcnt vmcnt(0)" ::: "memory");
        } else {
            XB_SPIN(xb_ld(&bar[XB_XGEN(x)]) == gen, bar);
            __builtin_amdgcn_fence(__ATOMIC_ACQUIRE, "agent");
            asm volatile("s_waitcnt vmcnt(0)" ::: "memory");
        }
    }
    __syncthreads();
}

__global__ void __launch_bounds__(512) fwd_kernel(Params p) {
    extern __shared__ __attribute__((aligned(16))) unsigned char lds[];
    cg::grid_group grid = cg::this_grid();
    const int tid = threadIdx.x, lane = tid & 63, wv = tid >> 6;
    const int G = gridDim.x, bx = blockIdx.x;
    const int vcu = ((G & 7) == 0) ? (bx % 8) * (G / 8) + bx / 8 : bx;
    unsigned char* ws = p.ws;
    const float* xp = p.in[0]; const float* xs = p.in[1];
    bf16_t* W1t = (bf16_t*)(ws + WS_W1T); bf16_t* Wuqt = (bf16_t*)(ws + WS_WUQT); bf16_t* Wukvt = (bf16_t*)(ws + WS_WUKVT);
    bf16_t* Woutt = (bf16_t*)(ws + WS_WOUTT); bf16_t* Wgut = (bf16_t*)(ws + WS_WGUT); bf16_t* Wdnt = (bf16_t*)(ws + WS_WDNT);
    float* mod = (float*)(ws + WS_MOD);
    float* cosA = (float*)(ws + WS_COSA); float* sinA = (float*)(ws + WS_SINA); float* cosB = (float*)(ws + WS_COSB); float* sinB = (float*)(ws + WS_SINB);
    float* rsq = (float*)(ws + WS_RSQ); float* rskv = (float*)(ws + WS_RSKV);
    bf16_t* U = (bf16_t*)(ws + WS_U); bf16_t* H = (bf16_t*)(ws + WS_H); bf16_t* Ob = (bf16_t*)(ws + WS_O);
    bf16_t* Qa = (bf16_t*)(ws + WS_QA); bf16_t* Ka = (bf16_t*)(ws + WS_KA); bf16_t* Vta = (bf16_t*)(ws + WS_VTA);
    bf16_t* Qm = (bf16_t*)(ws + WS_QM); bf16_t* Kn = (bf16_t*)(ws + WS_KN); bf16_t* Kpe = (bf16_t*)(ws + WS_KPE); bf16_t* Vtm = (bf16_t*)(ws + WS_VTM);
    bf16_t* F = (bf16_t*)(ws + WS_F);
    float* out = p.out;
    const int lo = p.lo, hi_ = p.hi;
#ifndef PH_MASK
#define PH_MASK 0xFFF
#endif
#define IN(k) (((PH_MASK >> (k)) & 1) && lo <= (k) && (k) < hi_)
#define SEAM(k) do { if (IN(k) && IN((k) + 1)) { if ((k) == 0) grid.sync(); else xcd_barrier(xbar, xcc, xst, tid == 0); } } while (0)
    unsigned* const xbar = (unsigned*)(p.ws + WS_BAR);
    volatile LAS unsigned* const xst = (volatile LAS unsigned*)((LAS unsigned char*)lds + LDS_XST);
    const unsigned xcc = xb_xcc_id();
    if (tid == 0) { xst[0] = 0u; xst[1] = 0u; (void)xb_add(&xbar[XB_XCNT(xcc)], 1u); }
    __syncthreads();

    if (IN(0)) {
        float* s_c = (float*)lds;
        float* red = (float*)(lds + 65536);
        const float* cpr = p.in[2]; const float* csm = p.in[3]; const float* w_ada = p.in[4]; const float* b_ada = p.in[5];
        for (int cb = bx; cb < 192; cb += G) {
            for (int i = tid; i < 16 * 1024; i += 512) {
                const int b = i >> 10, k = i & 1023; const float c = (b < 8) ? cpr[b * 1024 + k] : csm[(b - 8) * 1024 + k];
                s_c[i] = c / (1.0f + __expf(-c));
            }
            __syncthreads();
            const int kgp = tid >> 5, cl = tid & 31, col = cb * 32 + cl;
            float a[16];
#pragma unroll
            for (int b = 0; b < 16; ++b) a[b] = 0.f;
            for (int k = kgp * 64; k < kgp * 64 + 64; ++k) {
                const float w = w_ada[(size_t)k * 6144 + col];
#pragma unroll
                for (int b = 0; b < 16; ++b) a[b] += s_c[b * 1024 + k] * w;
            }
#pragma unroll
            for (int b = 0; b < 16; ++b) red[(kgp * 16 + b) * 32 + cl] = a[b];
            __syncthreads();
            { const int b = tid >> 5; float s = 0.f;
#pragma unroll
              for (int k2 = 0; k2 < 16; ++k2) s += red[(k2 * 16 + b) * 32 + cl];
              mod[b * 6144 + col] = s + b_ada[col]; }
            __syncthreads();
        }
        const int gtid = bx * 512 + tid, gth = G * 512;
        for (int i = gtid; i < 8192 * 48; i += gth) {
            const int s = i / 48, j = i - s * 48;
            int ii, n; if (j < 32) { ii = j; n = 16; } else { ii = j - 32; n = 8; }
            const int pos = (ii < n) ? (s >> 6) : (s & 63); const int fi = (ii < n) ? ii : ii - n;
            const float inv = exp2f(-((float)fi / (float)n) * 13.287712379549449f);
            const float ang = (float)pos * inv;
            const double rev = (double)ang * 0.15915494309189535; const float fr_ = (float)(rev - floor(rev));
            const float cv = __builtin_amdgcn_cosf(fr_), sv = __builtin_amdgcn_sinf(fr_);
            if (j < 32) { cosA[s * 32 + ii] = cv; sinA[s * 32 + ii] = sv; } else { cosB[s * 16 + ii] = cv; sinB[s * 16 + ii] = sv; }
        }
        conv_weight<0>(p.in[6], 1024, 1184, W1t, 1024, nullptr, nullptr, gtid, gth);
        for (int i = gtid; i < 96 * 1024 / 8; i += gth) *reinterpret_cast<u32x4*>(W1t + (size_t)1184 * 1024 + (size_t)i * 8) = (u32x4){0u, 0u, 0u, 0u};
        conv_weight<1>(p.in[10], 256, 768, Wuqt, 256, p.in[9], nullptr, gtid, gth);
        conv_weight<1>(p.in[12], 128, 1024, Wukvt, 256, p.in[11], nullptr, gtid, gth);
        for (int i = gtid; i < 1024 * 16; i += gth) { const int r = i >> 4, c = i & 15; *reinterpret_cast<u32x4*>(Wukvt + (size_t)r * 256 + 128 + c * 8) = (u32x4){0u, 0u, 0u, 0u}; }
        conv_weight<2>(p.in[15], 1024, 1024, Woutt, 1024, p.in[13], p.in[14], gtid, gth);
        conv_weight<3>(p.in[18], 1024, 2816, Wgut, 1024, nullptr, nullptr, gtid, gth);
        conv_weight<4>(p.in[19], 1024, 2816, Wgut, 1024, nullptr, nullptr, gtid, gth);
        conv_weight<0>(p.in[20], 2816, 1024, Wdnt, 2816, nullptr, nullptr, gtid, gth);
    }
    SEAM(0);

    if (IN(1)) {
        constexpr int NR = 4;
        for (int t0 = bx * 8 + wv; t0 < T; t0 += NR * G * 8) {
            f32x4 v[NR][4];
#pragma unroll
            for (int rr = 0; rr < NR; ++rr) {
                const int t = t0 + rr * G * 8; const float* xr = xrow(xp, xs, t < T ? t : t0);
#pragma unroll
                for (int c = 0; c < 4; ++c) v[rr][c] = *reinterpret_cast<const f32x4*>(xr + c * 256 + lane * 4);
            }
#pragma unroll
            for (int rr = 0; rr < NR; ++rr) {
                const int t = t0 + rr * G * 8;
                float s = 0.f;
#pragma unroll
                for (int c = 0; c < 4; ++c) s += (v[rr][c][0] + v[rr][c][1]) + (v[rr][c][2] + v[rr][c][3]);
                const float mean = wave_sum(s) * (1.0f / 1024.0f);
                float q = 0.f;
#pragma unroll
                for (int c = 0; c < 4; ++c) { v[rr][c] = v[rr][c] - mean; q += (v[rr][c][0] * v[rr][c][0] + v[rr][c][1] * v[rr][c][1]) + (v[rr][c][2] * v[rr][c][2] + v[rr][c][3] * v[rr][c][3]); }
                const float rstd = rsqrtf(wave_sum(q) * (1.0f / 1024.0f) + EPS);
                if (t < T) {
                    int b, S, tok0; tokinfo(t, b, S, tok0);
                    const float* md = mod + b * 6144;
#pragma unroll
                    for (int c = 0; c < 4; ++c) {
                        const int col = c * 256 + lane * 4;
                        const f32x4 sh = *reinterpret_cast<const f32x4*>(md + col), sc = *reinterpret_cast<const f32x4*>(md + 1024 + col);
                        const f32x4 y = v[rr][c] * rstd * (sc + 1.0f) + sh;
                        *reinterpret_cast<u32x2*>(U + (size_t)t * DM + col) = (u32x2){cvtpk(y[0], y[1]), cvtpk(y[2], y[3])};
                    }
                }
            }
        }
    }
    SEAM(1);

    if (IN(2)) {
        int pm, pn;
        for (int i = 0; tile_next(i, G, bx, NMT, 5, pm, pn); ++i) {
            f32x4 acc[2][2][4][2];
            const int brow = pm * 256, bcol = pn * 256;
            int b, S, tok0; tokinfo(brow, b, S, tok0);
            if (pn == 2) {
                gemm_core<false>(lds, U, DM, W1t, DM, 16, brow, bcol, acc);
                EPI_GEOM
#pragma unroll
                for (int ai = 0; ai < 2; ++ai)
#pragma unroll
                    for (int m = 0; m < 4; ++m) {
                        asm volatile("" ::: "memory"); const int row = brow + ai * 128 + wr * 64 + m * 16 + fq * 4;
#pragma unroll
                        for (int bj = 0; bj < 2; ++bj)
#pragma unroll
                            for (int n = 0; n < 2; ++n) {
                                const int col = bcol + bj * 128 + wc * 32 + n * 16 + fr; const f32x4 v = acc[ai][bj][m][n];
                                if (bj == 1) {
                                    const size_t off = (size_t)tok0 * 128 + (size_t)(col - 640) * S + (row - tok0);
                                    *reinterpret_cast<u32x2*>(Vta + off) = (u32x2){cvtpk(v[0], v[1]), cvtpk(v[2], v[3])};
                                } else {
#pragma unroll
                                    for (int j = 0; j < 4; ++j) H[(size_t)(row + j) * HP + col] = f2bf(v[j]);
                                }
                            }
                    }
            } else {
                gemm_core<true>(lds, U, DM, W1t, DM, 16, brow, bcol, acc);
                EPI_GEOM
#pragma unroll
                for (int ai = 0; ai < 2; ++ai)
#pragma unroll
                    for (int m = 0; m < 4; ++m) {
                        asm volatile("" ::: "memory"); const int row = brow + ai * 128 + wr * 64 + m * 16 + fr;
#pragma unroll
                        for (int bj = 0; bj < 2; ++bj)
#pragma unroll
                            for (int n = 0; n < 2; ++n) {
                                const int c0 = bcol + bj * 128 + wc * 32 + n * 16 + fq * 4; const f32x4 v = acc[ai][bj][m][n];
                                *reinterpret_cast<u32x2*>(H + (size_t)row * HP + c0) = (u32x2){cvtpk(v[0], v[1]), cvtpk(v[2], v[3])};
                            }
                    }
                if (pn >= 3) {
                    float* part = (float*)(ws + (pn == 3 ? WS_PQ : WS_PKV));
#pragma unroll
                    for (int ai = 0; ai < 2; ++ai)
#pragma unroll
                        for (int m = 0; m < 4; ++m) {
                            const int row = brow + ai * 128 + wr * 64 + m * 16 + fr;
                            float sq = 0.f;
#pragma unroll
                            for (int n = 0; n < 2; ++n) {
                                const f32x4 v0 = acc[ai][0][m][n], v1 = acc[ai][1][m][n];
                                sq += (v0[0] * v0[0] + v0[1] * v0[1]) + (v0[2] * v0[2] + v0[3] * v0[3]);
                                if (pn == 3) sq += (v1[0] * v1[0] + v1[1] * v1[1]) + (v1[2] * v1[2] + v1[3] * v1[3]);
                            }
                            sq += __shfl_xor(sq, 16); sq += __shfl_xor(sq, 32);
                            part[(size_t)row * 4 + wc] = sq;
                        }
                }
            }
        }
    }
    SEAM(2);

    if (IN(3)) {
        const float* gq = p.in[7]; const float* gk = p.in[8];
        for (int t = bx * 8 + wv; t < T; t += G * 8) {
            int b, S, tok0; tokinfo(t, b, S, tok0); const int s = t - tok0;
            const bf16_t* hr = H + (size_t)t * HP;
            if (lane < 40) {
                const int hh = lane >> 2, c = lane & 3; const bool isq = hh < 8;
                const u32x4 a1 = *reinterpret_cast<const u32x4*>(hr + hh * 64 + c * 8), a2 = *reinterpret_cast<const u32x4*>(hr + hh * 64 + 32 + c * 8);
                float x1[8], x2[8]; float ss = 0.f;
#pragma unroll
                for (int e = 0; e < 4; ++e) {
                    x1[2 * e] = __uint_as_float(a1[e] << 16); x1[2 * e + 1] = __uint_as_float(a1[e] & 0xffff0000u);
                    x2[2 * e] = __uint_as_float(a2[e] << 16); x2[2 * e + 1] = __uint_as_float(a2[e] & 0xffff0000u);
                }
#pragma unroll
                for (int e = 0; e < 8; ++e) ss += x1[e] * x1[e] + x2[e] * x2[e];
                ss += __shfl_xor(ss, 1); ss += __shfl_xor(ss, 2);
                const float rstd = rsqrtf(ss * (1.0f / 64.0f) + EPS);
                const float* g = isq ? gq : gk; const float scl = isq ? C2A : 1.0f;
                float o1[8], o2[8];
#pragma unroll
                for (int e = 0; e < 8; ++e) {
                    const int d1 = c * 8 + e;
                    const float a = x1[e] * rstd * g[d1], bb = x2[e] * rstd * g[d1 + 32];
                    const float cs = cosA[s * 32 + d1], sn = sinA[s * 32 + d1];
                    o1[e] = (a * cs - bb * sn) * scl; o2[e] = (a * sn + bb * cs) * scl;
                }
                bf16_t* dst = isq ? (Qa + (size_t)t * 512 + hh * 64 + c * 8) : (Ka + (size_t)t * 128 + (hh - 8) * 64 + c * 8);
                *reinterpret_cast<u32x4*>(dst) = (u32x4){cvtpk(o1[0], o1[1]), cvtpk(o1[2], o1[3]), cvtpk(o1[4], o1[5]), cvtpk(o1[6], o1[7])};
                *reinterpret_cast<u32x4*>(dst + 32) = (u32x4){cvtpk(o2[0], o2[1]), cvtpk(o2[2], o2[3]), cvtpk(o2[4], o2[5]), cvtpk(o2[6], o2[7])};
            }
            if (lane < 2) {
                const u32x4 a1 = *reinterpret_cast<const u32x4*>(hr + 1152 + lane * 8), a2 = *reinterpret_cast<const u32x4*>(hr + 1152 + 16 + lane * 8);
                float o1[8], o2[8];
#pragma unroll
                for (int e = 0; e < 4; ++e) {
#pragma unroll
                    for (int h2 = 0; h2 < 2; ++h2) {
                        const int ee = 2 * e + h2, i = lane * 8 + ee;
                        const float a = h2 ? __uint_as_float(a1[e] & 0xffff0000u) : __uint_as_float(a1[e] << 16);
                        const float bb = h2 ? __uint_as_float(a2[e] & 0xffff0000u) : __uint_as_float(a2[e] << 16);
                        const float cs = cosB[s * 16 + i], sn = sinB[s * 16 + i];
                        o1[ee] = a * cs - bb * sn; o2[ee] = a * sn + bb * cs;
                    }
                }
                bf16_t* dst = Kpe + (size_t)t * 32 + lane * 8;
                *reinterpret_cast<u32x4*>(dst) = (u32x4){cvtpk(o1[0], o1[1]), cvtpk(o1[2], o1[3]), cvtpk(o1[4], o1[5]), cvtpk(o1[6], o1[7])};
                *reinterpret_cast<u32x4*>(dst + 16) = (u32x4){cvtpk(o2[0], o2[1]), cvtpk(o2[2], o2[3]), cvtpk(o2[4], o2[5]), cvtpk(o2[6], o2[7])};
            }
        }
    }

    if (IN(4)) {
        int pm, pn;
        for (int i = 0; tile_next(i, G, bx, NMT, 7, pm, pn); ++i) {
            f32x4 acc[2][2][4][2];
            const int brow = pm * 256;
            const bool isq = pn < 3;
            const bf16_t* A = H + (isq ? 768 : 1024);
            const bf16_t* Bt = isq ? Wuqt : Wukvt;
            const int bcol = isq ? pn * 256 : (pn - 3) * 256;
            int b, S, tok0; tokinfo(brow, b, S, tok0);
            if (isq) {
                gemm_core<true>(lds, A, HP, Bt, 256, 4, brow, bcol, acc);
                EPI_GEOM
#pragma unroll
                for (int ai = 0; ai < 2; ++ai)
#pragma unroll
                    for (int m = 0; m < 4; ++m) {
                        asm volatile("" ::: "memory"); const int row = brow + ai * 128 + wr * 64 + m * 16 + fr;
                        const f32x4 pq = *reinterpret_cast<const f32x4*>((const float*)(ws + WS_PQ) + (size_t)row * 4);
                        const float rs = rsqrtf(((pq[0] + pq[1]) + (pq[2] + pq[3])) * (1.0f / 256.0f) + EPS) * C2M; const int sp = row - tok0;
                        const f32x4 cs = *reinterpret_cast<const f32x4*>(cosB + sp * 16 + fq * 4), sn = *reinterpret_cast<const f32x4*>(sinB + sp * 16 + fq * 4);
#pragma unroll
                        for (int bj = 0; bj < 2; ++bj) {
                            const int g32 = pn * 8 + bj * 4 + wc; const bool isrope = (g32 % 3) == 2; const int colb = g32 * 32 + fq * 4;
                            f32x4 v0 = acc[ai][bj][m][0] * rs, v1 = acc[ai][bj][m][1] * rs;
                            if (isrope) { const f32x4 ra = v0 * cs - v1 * sn, rb = v0 * sn + v1 * cs; v0 = ra; v1 = rb; }
                            *reinterpret_cast<u32x2*>(Qm + (size_t)row * 768 + colb) = (u32x2){cvtpk(v0[0], v0[1]), cvtpk(v0[2], v0[3])};
                            *reinterpret_cast<u32x2*>(Qm + (size_t)row * 768 + colb + 16) = (u32x2){cvtpk(v1[0], v1[1]), cvtpk(v1[2], v1[3])};
                        }
                    }
            } else {
                gemm_core<false>(lds, A, HP, Bt, 256, 4, brow, bcol, acc);
                EPI_GEOM
#pragma unroll
                for (int ai = 0; ai < 2; ++ai)
#pragma unroll
                    for (int m = 0; m < 4; ++m) {
                        asm volatile("" ::: "memory"); const int row = brow + ai * 128 + wr * 64 + m * 16 + fq * 4;
                        float rs[4];
#pragma unroll
                        for (int j = 0; j < 4; ++j) { const f32x4 pk = *reinterpret_cast<const f32x4*>((const float*)(ws + WS_PKV) + (size_t)(row + j) * 4); rs[j] = rsqrtf(((pk[0] + pk[1]) + (pk[2] + pk[3])) * (1.0f / 128.0f) + EPS); }
#pragma unroll
                        for (int bj = 0; bj < 2; ++bj) {
                            const int head = (pn - 3) * 2 + bj;
#pragma unroll
                            for (int n = 0; n < 2; ++n) {
                                const int within = wc * 32 + n * 16 + fr; const f32x4 v = acc[ai][bj][m][n];
                                if (wc < 2) {
#pragma unroll
                                    for (int j = 0; j < 4; ++j) Kn[(size_t)(row + j) * 512 + head * 64 + within] = f2bf(v[j] * rs[j]);
                                } else {
                                    const size_t off = (size_t)tok0 * 512 + (size_t)(head * 64 + within - 64) * S + (row - tok0);
                                    *reinterpret_cast<u32x2*>(Vtm + off) = (u32x2){cvtpk(v[0] * rs[0], v[1] * rs[1]), cvtpk(v[2] * rs[2], v[3] * rs[3])};
                                }
                            }
                        }
                    }
            }
        }
    }
    SEAM(4);

    if (IN(5)) {
#ifndef NO_MLA
        for (int u = vcu; u < 1280; u += G) {
            const bool smp = u < 1024; const int idx = smp ? u : u - 1024;
            const int S = smp ? 8192 : 2048;
            const int nqb = S / 512, qb = idx % nqb, head = (idx / nqb) & 7, bl = idx / (nqb * 8);
            const int tok0 = smp ? TP + bl * 8192 : bl * 2048, q0 = tok0 + qb * 512;
            const bf16_t* q = Qm + (size_t)q0 * 768 + head * 96; bf16_t* o = Ob + (size_t)q0 * DM + 512 + head * 64;
            attn_unit2<96>(lds, q, q + (size_t)256 * 768, 768, Kn + (size_t)tok0 * 512 + head * 64, 512, Kpe + (size_t)tok0 * 32,
                           Vtm + (size_t)tok0 * 512 + (size_t)head * 64 * S, S, o, o + (size_t)256 * DM);
        }
#endif
#ifndef NO_GQA
        for (int u = vcu; u < 1280; u += G) {
            const bool smp = u < 1024; const int idx = smp ? u : u - 1024;
            const int S = smp ? 8192 : 2048;
            const int nqb = S / 256, qb = idx % nqb, hp = (idx / nqb) & 3, bl = idx / (nqb * 4);
            const int kvh = hp >> 1, head = hp * 2;
            const int tok0 = smp ? TP + bl * 8192 : bl * 2048, q0 = tok0 + qb * 256;
            const bf16_t* q = Qa + (size_t)q0 * 512 + head * 64; bf16_t* o = Ob + (size_t)q0 * DM + head * 64;
            attn_unit2<64>(lds, q, q + 64, 512, Ka + (size_t)tok0 * 128 + kvh * 64, 128, nullptr,
                           Vta + (size_t)tok0 * 128 + (size_t)kvh * 64 * S, S, o, o + 64);
        }
#endif
    }
    SEAM(5);

    if (IN(6)) {
        constexpr int NR = 4;
        for (int t0 = bx * 8 + wv; t0 < T; t0 += NR * G * 8) {
            u32x4 ra[NR], rc[NR];
#pragma unroll
            for (int rr = 0; rr < NR; ++rr) {
                const int t = t0 + rr * G * 8; const bf16_t* orow = Ob + (size_t)(t < T ? t : t0) * DM + lane * 16;
                ra[rr] = *reinterpret_cast<const u32x4*>(orow); rc[rr] = *reinterpret_cast<const u32x4*>(orow + 8);
            }
#pragma unroll
            for (int rr = 0; rr < NR; ++rr) {
                const int t = t0 + rr * G * 8;
                float x[16];
#pragma unroll
                for (int e = 0; e < 4; ++e) { x[2 * e] = __uint_as_float(ra[rr][e] << 16); x[2 * e + 1] = __uint_as_float(ra[rr][e] & 0xffff0000u); x[8 + 2 * e] = __uint_as_float(rc[rr][e] << 16); x[8 + 2 * e + 1] = __uint_as_float(rc[rr][e] & 0xffff0000u); }
                float ss = 0.f;
#pragma unroll
                for (int e = 0; e < 16; ++e) ss += x[e] * x[e];
#pragma unroll
                for (int o = 16; o >= 1; o >>= 1) ss += __shfl_xor(ss, o);
                const float rstd = rsqrtf(ss * (1.0f / 512.0f) + EPS);
#pragma unroll
                for (int e = 0; e < 16; ++e) x[e] *= rstd;
                if (t < T) {
                    bf16_t* orow = Ob + (size_t)t * DM + lane * 16;
                    *reinterpret_cast<u32x4*>(orow) = (u32x4){cvtpk(x[0], x[1]), cvtpk(x[2], x[3]), cvtpk(x[4], x[5]), cvtpk(x[6], x[7])};
                    *reinterpret_cast<u32x4*>(orow + 8) = (u32x4){cvtpk(x[8], x[9]), cvtpk(x[10], x[11]), cvtpk(x[12], x[13]), cvtpk(x[14], x[15])};
                }
            }
        }
    }
    SEAM(6);

    if (IN(7)) {
        int pm, pn;
        for (int i = 0; tile_next(i, G, bx, NMT, 4, pm, pn); ++i) {
            f32x4 acc[2][2][4][2];
            const int brow = pm * 256, bcol = pn * 256;
            gemm_core<true>(lds, Ob, DM, Woutt, DM, 16, brow, bcol, acc);
            EPI_GEOM
            int b, S, tok0; tokinfo(brow, b, S, tok0);
            const float* g1 = mod + b * 6144 + 2048;
            const int cl = wc * 32 + fq * 4;
            f32x4 gv[2][2], xv[2][2][2];
#pragma unroll
            for (int bj = 0; bj < 2; ++bj)
#pragma unroll
                for (int n = 0; n < 2; ++n) gv[bj][n] = *reinterpret_cast<const f32x4*>(g1 + bcol + bj * 128 + n * 16 + cl);
            { const float* xr = xrow(xp, xs, brow + wr * 64 + fr);
#pragma unroll
              for (int bj = 0; bj < 2; ++bj)
#pragma unroll
                  for (int n = 0; n < 2; ++n) xv[0][bj][n] = *reinterpret_cast<const f32x4*>(xr + bcol + bj * 128 + n * 16 + cl); }
#pragma unroll
            for (int it = 0; it < 8; ++it) {
                const int ai = it >> 2, m = it & 3;
                if (it + 1 < 8) {
                    const float* xr = xrow(xp, xs, brow + ((it + 1) >> 2) * 128 + wr * 64 + ((it + 1) & 3) * 16 + fr);
#pragma unroll
                    for (int bj = 0; bj < 2; ++bj)
#pragma unroll
                        for (int n = 0; n < 2; ++n) xv[(it + 1) & 1][bj][n] = *reinterpret_cast<const f32x4*>(xr + bcol + bj * 128 + n * 16 + cl);
                }
                const int row = brow + ai * 128 + wr * 64 + m * 16 + fr;
#pragma unroll
                for (int bj = 0; bj < 2; ++bj)
#pragma unroll
                    for (int n = 0; n < 2; ++n)
                        *reinterpret_cast<f32x4*>(out + (size_t)row * DM + bcol + bj * 128 + n * 16 + cl) = xv[it & 1][bj][n] * ALPHA + gv[bj][n] * acc[ai][bj][m][n];
                asm volatile("" ::: "memory");
            }
        }
    }
    SEAM(7);

    if (IN(8)) {
        const float* l1g = p.in[16]; const float* l1b = p.in[17];
        constexpr int NR = 4;
        for (int t0 = bx * 8 + wv; t0 < T; t0 += NR * G * 8) {
            f32x4 v[NR][4];
#pragma unroll
            for (int rr = 0; rr < NR; ++rr) {
                const int t = t0 + rr * G * 8; const float* orow = out + (size_t)(t < T ? t : t0) * DM;
#pragma unroll
                for (int c = 0; c < 4; ++c) v[rr][c] = *reinterpret_cast<const f32x4*>(orow + c * 256 + lane * 4);
            }
#pragma unroll
            for (int rr = 0; rr < NR; ++rr) {
                const int t = t0 + rr * G * 8;
                float* orow = out + (size_t)t * DM;
                float s = 0.f;
#pragma unroll
                for (int c = 0; c < 4; ++c) s += (v[rr][c][0] + v[rr][c][1]) + (v[rr][c][2] + v[rr][c][3]);
                float mean = wave_sum(s) * (1.0f / 1024.0f);
                float q = 0.f;
#pragma unroll
                for (int c = 0; c < 4; ++c) { v[rr][c] = v[rr][c] - mean; q += (v[rr][c][0] * v[rr][c][0] + v[rr][c][1] * v[rr][c][1]) + (v[rr][c][2] * v[rr][c][2] + v[rr][c][3] * v[rr][c][3]); }
                float rstd = rsqrtf(wave_sum(q) * (1.0f / 1024.0f) + EPS);
                s = 0.f;
#pragma unroll
                for (int c = 0; c < 4; ++c) {
                    const int col = c * 256 + lane * 4;
                    v[rr][c] = v[rr][c] * rstd * *reinterpret_cast<const f32x4*>(l1g + col) + *reinterpret_cast<const f32x4*>(l1b + col);
                    if (t < T) *reinterpret_cast<f32x4*>(orow + col) = v[rr][c];
                    s += (v[rr][c][0] + v[rr][c][1]) + (v[rr][c][2] + v[rr][c][3]);
                }
                mean = wave_sum(s) * (1.0f / 1024.0f);
                q = 0.f;
#pragma unroll
                for (int c = 0; c < 4; ++c) { v[rr][c] = v[rr][c] - mean; q += (v[rr][c][0] * v[rr][c][0] + v[rr][c][1] * v[rr][c][1]) + (v[rr][c][2] * v[rr][c][2] + v[rr][c][3] * v[rr][c][3]); }
                rstd = rsqrtf(wave_sum(q) * (1.0f / 1024.0f) + EPS);
                if (t < T) {
                    int b, S, tok0; tokinfo(t, b, S, tok0);
                    const float* md = mod + b * 6144;
#pragma unroll
                    for (int c = 0; c < 4; ++c) {
                        const int col = c * 256 + lane * 4;
                        const f32x4 sh = *reinterpret_cast<const f32x4*>(md + 3072 + col), sc = *reinterpret_cast<const f32x4*>(md + 4096 + col);
                        const f32x4 y = v[rr][c] * rstd * (sc + 1.0f) + sh;
                        *reinterpret_cast<u32x2*>(U + (size_t)t * DM + col) = (u32x2){cvtpk(y[0], y[1]), cvtpk(y[2], y[3])};
                    }
                }
            }
        }
    }
    SEAM(8);

    if (IN(9)) {
        int pm, pn;
        for (int i = 0; tile_next(i, G, bx, NMT, 22, pm, pn); ++i) {
            f32x4 acc[2][2][4][2];
            const int brow = pm * 256, bcol = pn * 256;
            gemm_core<true>(lds, U, DM, Wgut, DM, 16, brow, bcol, acc);
            EPI_GEOM
#pragma unroll
            for (int ai = 0; ai < 2; ++ai)
#pragma unroll
                for (int m = 0; m < 4; ++m) {
                    asm volatile("" ::: "memory"); const int row = brow + ai * 128 + wr * 64 + m * 16 + fr;
#pragma unroll
                    for (int n = 0; n < 2; ++n) {
                        const int c0 = pn * 128 + wc * 32 + n * 16 + fq * 4; const f32x4 g = acc[ai][0][m][n], uu = acc[ai][1][m][n];
                        float f[4];
#pragma unroll
                        for (int j = 0; j < 4; ++j) {
                            const float e = __builtin_amdgcn_exp2f(-LOG2E * g[j]);
                            f[j] = g[j] * __builtin_amdgcn_rcpf(1.0f + e) * uu[j];
                        }
                        *reinterpret_cast<u32x2*>(F + (size_t)row * DFF + c0) = (u32x2){cvtpk(f[0], f[1]), cvtpk(f[2], f[3])};
                    }
                }
        }
    }
    SEAM(9);

    if (IN(10)) {
        int pm, pn;
        for (int i = 0; tile_next(i, G, bx, NMT, 4, pm, pn); ++i) {
            f32x4 acc[2][2][4][2];
            const int brow = pm * 256, bcol = pn * 256;
            gemm_core<true>(lds, F, DFF, Wdnt, DFF, 44, brow, bcol, acc);
            EPI_GEOM
            int b, S, tok0; tokinfo(brow, b, S, tok0);
            const float* g2 = mod + b * 6144 + 5120;
            const int cl = wc * 32 + fq * 4;
            f32x4 gv[2][2], xv[2][2][2];
#pragma unroll
            for (int bj = 0; bj < 2; ++bj)
#pragma unroll
                for (int n = 0; n < 2; ++n) gv[bj][n] = *reinterpret_cast<const f32x4*>(g2 + bcol + bj * 128 + n * 16 + cl);
            { const float* xr = out + (size_t)(brow + wr * 64 + fr) * DM;
#pragma unroll
              for (int bj = 0; bj < 2; ++bj)
#pragma unroll
                  for (int n = 0; n < 2; ++n) xv[0][bj][n] = *reinterpret_cast<const f32x4*>(xr + bcol + bj * 128 + n * 16 + cl); }
#pragma unroll
            for (int it = 0; it < 8; ++it) {
                const int ai = it >> 2, m = it & 3;
                if (it + 1 < 8) {
                    const float* xr = out + (size_t)(brow + ((it + 1) >> 2) * 128 + wr * 64 + ((it + 1) & 3) * 16 + fr) * DM;
#pragma unroll
                    for (int bj = 0; bj < 2; ++bj)
#pragma unroll
                        for (int n = 0; n < 2; ++n) xv[(it + 1) & 1][bj][n] = *reinterpret_cast<const f32x4*>(xr + bcol + bj * 128 + n * 16 + cl);
                }
                const int row = brow + ai * 128 + wr * 64 + m * 16 + fr;
#pragma unroll
                for (int bj = 0; bj < 2; ++bj)
#pragma unroll
                    for (int n = 0; n < 2; ++n)
                        *reinterpret_cast<f32x4*>(out + (size_t)row * DM + bcol + bj * 128 + n * 16 + cl) = xv[it & 1][bj][n] * ALPHA + gv[bj][n] * acc[ai][bj][m][n];
                asm volatile("" ::: "memory");
            }
        }
    }
    SEAM(10);

    if (IN(11)) {
        const float* l2g = p.in[21]; const float* l2b = p.in[22];
        constexpr int NR = 4;
        for (int t0 = bx * 8 + wv; t0 < T; t0 += NR * G * 8) {
            f32x4 v[NR][4];
#pragma unroll
            for (int rr = 0; rr < NR; ++rr) {
                const int t = t0 + rr * G * 8; const float* orow = out + (size_t)(t < T ? t : t0) * DM;
#pragma unroll
                for (int c = 0; c < 4; ++c) v[rr][c] = *reinterpret_cast<const f32x4*>(orow + c * 256 + lane * 4);
            }
#pragma unroll
            for (int rr = 0; rr < NR; ++rr) {
                const int t = t0 + rr * G * 8;
                float* orow = out + (size_t)t * DM;
                float s = 0.f;
#pragma unroll
                for (int c = 0; c < 4; ++c) s += (v[rr][c][0] + v[rr][c][1]) + (v[rr][c][2] + v[rr][c][3]);
                const float mean = wave_sum(s) * (1.0f / 1024.0f);
                float q = 0.f;
#pragma unroll
                for (int c = 0; c < 4; ++c) { v[rr][c] = v[rr][c] - mean; q += (v[rr][c][0] * v[rr][c][0] + v[rr][c][1] * v[rr][c][1]) + (v[rr][c][2] * v[rr][c][2] + v[rr][c][3] * v[rr][c][3]); }
                const float rstd = rsqrtf(wave_sum(q) * (1.0f / 1024.0f) + EPS);
                if (t < T) {
#pragma unroll
                    for (int c = 0; c < 4; ++c) {
                        const int col = c * 256 + lane * 4;
                        *reinterpret_cast<f32x4*>(orow + col) = v[rr][c] * rstd * *reinterpret_cast<const f32x4*>(l2g + col) + *reinterpret_cast<const f32x4*>(l2b + col);
                    }
                }
            }
        }
    }
#undef IN
#undef SEAM
}

extern "C" void kernel_launch(void* const* d_in, const int* in_sizes, int n_in, void* d_out, int out_size, void* d_ws, size_t ws_size, hipStream_t stream) {
    static int grid_blocks = 0;
    if (grid_blocks == 0) {
        if (n_in != 23 || out_size != T * DM || ws_size < WS_END) { fprintf(stderr, "kernel_launch: unexpected shapes (n_in %d out %d ws %zu)\n", n_in, out_size, ws_size); grid_blocks = -1; return; }
        int dev = 0, cus = 0, per_cu = 0;
        hipGetDevice(&dev);
        hipDeviceGetAttribute(&cus, hipDeviceAttributeMultiprocessorCount, dev);
        if (hipFuncSetAttribute((const void*)fwd_kernel, hipFuncAttributeMaxDynamicSharedMemorySize, LDS_BYTES) != hipSuccess) { fprintf(stderr, "kernel_launch: hipFuncSetAttribute failed\n"); grid_blocks = -1; return; }
        if (hipOccupancyMaxActiveBlocksPerMultiprocessor(&per_cu, (const void*)fwd_kernel, 512, LDS_BYTES) != hipSuccess || per_cu < 1) { fprintf(stderr, "kernel_launch: occupancy query says %d\n", per_cu); per_cu = 1; }
        (void)hipGetLastError();
        grid_blocks = cus;
    }
    if (grid_blocks < 0) return;
    if (hipMemsetAsync((char*)d_ws + WS_BAR, 0, XCD_BAR_WORDS * 4, stream) != hipSuccess) { fprintf(stderr, "kernel_launch: hipMemsetAsync failed\n"); return; }
    Params p{};
    for (int i = 0; i < 23; ++i) p.in[i] = (const float*)d_in[i];
    p.out = (float*)d_out; p.ws = (unsigned char*)d_ws; p.lo = 0; p.hi = NPHASE;
    void* args[] = {&p};
    hipError_t e = hipLaunchCooperativeKernel((const void*)fwd_kernel, dim3(grid_blocks), dim3(512), args, LDS_BYTES, stream);
    if (e != hipSuccess) fprintf(stderr, "kernel_launch: cooperative launch failed: %s (grid %d)\n", hipGetErrorString(e), grid_blocks);
}
```

```cpp
#include <hip/hip_runtime.h>
#include <hip/hip_cooperative_groups.h>
#include <cstdio>
#include <cstdint>
namespace cg = cooperative_groups;

typedef unsigned short bf16_t;
typedef short bf16x8 __attribute__((ext_vector_type(8)));
typedef float f32x4 __attribute__((ext_vector_type(4)));
typedef float f32x16 __attribute__((ext_vector_type(16)));
typedef unsigned u32x4 __attribute__((ext_vector_type(4)));
typedef unsigned u32x2 __attribute__((ext_vector_type(2)));
typedef float f32x2_t __attribute__((ext_vector_type(2)));
typedef __bf16 bf16x2_t __attribute__((ext_vector_type(2)));

constexpr int DM = 1024, TP = 8 * 2048, TSMP = 8 * 8192, T = TP + TSMP;
constexpr int HP = 1280;
constexpr int DFF = 2816;
constexpr int NMT = T / 256;
constexpr float EPS = 1e-6f;
constexpr float ALPHA = 1.189207115002721f;
constexpr float LOG2E = 1.4426950408889634f;
constexpr float C2A = 0.125f * LOG2E;
constexpr float C2M = 0.10206207261596575f * LOG2E;

constexpr size_t MiB = 1u << 20;
constexpr size_t WS_W1T = 0;
constexpr size_t WS_WUQT = 3 * MiB;
constexpr size_t WS_WUKVT = 4 * MiB;
constexpr size_t WS_WOUTT = 5 * MiB;
constexpr size_t WS_WGUT = 7 * MiB;
constexpr size_t WS_WDNT = 18 * MiB;
constexpr size_t WS_MOD = 24 * MiB;
constexpr size_t WS_COSA = 25 * MiB;
constexpr size_t WS_SINA = 26 * MiB;
constexpr size_t WS_COSB = 27 * MiB;
constexpr size_t WS_SINB = 28 * MiB;
constexpr size_t WS_RSQ = 29 * MiB;
constexpr size_t WS_RSKV = 30 * MiB;
constexpr size_t WS_BAR = 31 * MiB;
constexpr size_t WS_U = 32 * MiB;
constexpr size_t WS_H = 192 * MiB;
constexpr size_t WS_O = 192 * MiB;
constexpr size_t WS_QA = 392 * MiB;
constexpr size_t WS_KA = 472 * MiB;
constexpr size_t WS_VTA = 492 * MiB;
constexpr size_t WS_QM = 512 * MiB;
constexpr size_t WS_KN = 632 * MiB;
constexpr size_t WS_KPE = 712 * MiB;
constexpr size_t WS_VTM = 717 * MiB;
constexpr size_t WS_F = 192 * MiB;
constexpr size_t WS_PQ = 800 * MiB;
constexpr size_t WS_PKV = 802 * MiB;
constexpr size_t WS_END = 804 * MiB;

constexpr int LDS_XST = 147456;
constexpr int LDS_BYTES = LDS_XST + 256;
constexpr int NPHASE = 12;

struct Params {
    const float* in[23];
    float* out;
    unsigned char* ws;
    int lo, hi;
};

__device__ __forceinline__ unsigned cvtpk(float lo, float hi) { f32x2_t v = {lo, hi}; bf16x2_t b = __builtin_convertvector(v, bf16x2_t); return __builtin_bit_cast(unsigned, b); }
__device__ __forceinline__ bf16_t f2bf(float f) { return (bf16_t)(cvtpk(f, 0.f) & 0xffffu); }
__device__ __forceinline__ float bf2f(unsigned short h) { return __uint_as_float(((unsigned)h) << 16); }
__device__ __forceinline__ float wave_sum(float v) {
#pragma unroll
    for (int o = 32; o >= 1; o >>= 1) v += __shfl_xor(v, o);
    return v;
}
__device__ __forceinline__ void tokinfo(int t, int& b, int& S, int& tok0) {
    if (t < TP) { b = t >> 11; S = 2048; tok0 = b << 11; }
    else { const int u = t - TP; const int bb = u >> 13; b = 8 + bb; S = 8192; tok0 = TP + (bb << 13); }
}
__device__ __forceinline__ const float* xrow(const float* xp, const float* xs, int t) {
    return t < TP ? xp + (size_t)t * DM : xs + (size_t)(t - TP) * DM;
}

constexpr int HTB = 128 * 64 * 2;
__device__ __forceinline__ int lds_byte(int r, int c) {
    const int st = (r >> 4) * 2 + (c >> 5), rr = r & 15, cc = c & 31, ob = rr * 64 + cc * 2;
    return st * 1024 + (ob ^ (((ob >> 9) & 1) << 5));
}
__device__ __forceinline__ void stage_rc(int b, int& R, int& C) {
    const int st = b / 1024, sb = b % 1024, swz = sb ^ (((sb >> 9) & 1) << 5);
    R = (st >> 1) * 16 + swz / 64; C = (st & 1) * 32 + (swz % 64) / 2;
}
__device__ __forceinline__ bool tile_next(int i, int G, int c, int nM, int nN, int& pm, int& pn) {
    const int nwg = nM * nN; const long L = (long)i * G + c; if (L >= nwg) return false;
    int wgid = (int)L;
    if ((G & 7) == 0) { const int q = nwg / 8, r = nwg % 8, xcd = wgid % 8, off = wgid / 8; wgid = (xcd < r ? xcd * (q + 1) : r * (q + 1) + (xcd - r) * q) + off; }
    const int nig = 8 * nN, gid = wgid / nig, fm = gid * 8, gsz = (nM - fm) < 8 ? (nM - fm) : 8;
    pm = fm + ((wgid % nig) % gsz); pn = (wgid % nig) / gsz; return true;
}

#define WAIT_V(n) asm volatile("s_waitcnt vmcnt(" #n ")" ::: "memory")
#define WAIT_L(n) asm volatile("s_waitcnt lgkmcnt(" #n ")" ::: "memory")
#define BAR __builtin_amdgcn_s_barrier()
#define SCHED __builtin_amdgcn_sched_barrier(0)

__device__ __forceinline__ void glds16(const void* sbase, unsigned voff, unsigned ldsdst) {
    unsigned keep;
    asm volatile("s_mov_b32 %0, m0\n\ts_mov_b32 m0, %3\n\ts_nop 0\n\tglobal_load_lds_dwordx4 %2, %1\n\ts_mov_b32 m0, %0"
                 : "=&s"(keep) : "s"(sbase), "v"(voff), "s"(ldsdst) : "memory");
}
template <bool TR>
__device__ __forceinline__ void gemm_core(unsigned char* shm, const bf16_t* __restrict__ A, int lda, const bf16_t* __restrict__ Bt, int ldb,
                                          int nt, int brow, int bcol, f32x4 (&acc)[2][2][4][2]) {
    const int wid = threadIdx.x >> 6, lane = threadIdx.x & 63, wr = wid >> 2, wc = wid & 3, fr = lane & 15, fq = lane >> 4;
    int sr0, sc0; stage_rc(threadIdx.x * 16, sr0, sc0);
    const unsigned offA = (unsigned)(sr0 * lda + sc0) * 2u, offB = (unsigned)(sr0 * ldb + sc0) * 2u;
    const unsigned ldsw = (unsigned)(uintptr_t)shm + (unsigned)__builtin_amdgcn_readfirstlane(wid) * 1024u;
#define SA(b, h) (shm + ((b) * 2 + (h)) * HTB)
#define SB(b, h) (shm + (4 + (b) * 2 + (h)) * HTB)
#define SAO(b, h) (((b) * 2 + (h)) * HTB)
#define SBO(b, h) ((4 + (b) * 2 + (h)) * HTB)
#define STAGE(PO, BASE, LD, VO, br, kt) do { \
        const char* b0_ = (const char*)(BASE) + ((long)(br) * (LD) + (long)(kt) * 64) * 2; \
        glds16(b0_, VO, ldsw + (PO)); glds16(b0_ + (long)(LD) * 128, VO, ldsw + (PO) + 8192u); } while (0)
#define LDA(dst, b, h) for (int m = 0; m < 4; ++m) for (int k = 0; k < 2; ++k) \
        dst[m][k] = *reinterpret_cast<const bf16x8*>(SA(b, h) + lds_byte(wr * 64 + m * 16 + fr, k * 32 + fq * 8))
#define LDB(dst, b, h) for (int n = 0; n < 2; ++n) for (int k = 0; k < 2; ++k) \
        dst[n][k] = *reinterpret_cast<const bf16x8*>(SB(b, h) + lds_byte(wc * 32 + n * 16 + fr, k * 32 + fq * 8))
#define MMA(ai, bj, At_, Bt_) do { __builtin_amdgcn_s_setprio(1); \
        for (int m = 0; m < 4; ++m) for (int n = 0; n < 2; ++n) for (int k = 0; k < 2; ++k) \
            acc[ai][bj][m][n] = TR ? __builtin_amdgcn_mfma_f32_16x16x32_bf16(Bt_[n][k], At_[m][k], acc[ai][bj][m][n], 0, 0, 0) \
                                   : __builtin_amdgcn_mfma_f32_16x16x32_bf16(At_[m][k], Bt_[n][k], acc[ai][bj][m][n], 0, 0, 0); \
        __builtin_amdgcn_s_setprio(0); } while (0)
    bf16x8 At[4][2], B0[2][2], B1[2][2];
#pragma unroll
    for (int a = 0; a < 2; ++a)
#pragma unroll
        for (int b = 0; b < 2; ++b)
#pragma unroll
            for (int m = 0; m < 4; ++m)
#pragma unroll
                for (int n = 0; n < 2; ++n) acc[a][b][m][n] = (f32x4){0.f, 0.f, 0.f, 0.f};
    STAGE(SBO(0, 0), Bt, ldb, offB, bcol, 0); STAGE(SAO(0, 0), A, lda, offA, brow, 0);
    STAGE(SBO(0, 1), Bt, ldb, offB, bcol + 128, 0); STAGE(SAO(0, 1), A, lda, offA, brow + 128, 0);
    if (wr == 1) BAR;
    WAIT_V(4); BAR;
    STAGE(SBO(1, 0), Bt, ldb, offB, bcol, 1); STAGE(SAO(1, 0), A, lda, offA, brow, 1); STAGE(SBO(1, 1), Bt, ldb, offB, bcol + 128, 1);
    WAIT_V(6); BAR;
    for (int t = 0; t < nt - 2; t += 2) {
        LDB(B0, 0, 0); SCHED; LDA(At, 0, 0); STAGE(SAO(1, 1), A, lda, offA, brow + 128, t + 1);
        WAIT_L(8); BAR; WAIT_L(0); MMA(0, 0, At, B0); BAR; SCHED;
        LDB(B1, 0, 1); STAGE(SBO(0, 0), Bt, ldb, offB, bcol, t + 2);
        BAR; WAIT_L(0); MMA(0, 1, At, B1); BAR;
        LDA(At, 0, 1); STAGE(SAO(0, 0), A, lda, offA, brow, t + 2);
        BAR; WAIT_L(0); MMA(1, 0, At, B0); BAR; SCHED;
        STAGE(SBO(0, 1), Bt, ldb, offB, bcol + 128, t + 2);
        WAIT_V(6); BAR; MMA(1, 1, At, B1); BAR;
        LDB(B0, 1, 0); SCHED; LDA(At, 1, 0); STAGE(SAO(0, 1), A, lda, offA, brow + 128, t + 2);
        WAIT_L(8); BAR; WAIT_L(0); MMA(0, 0, At, B0); BAR; SCHED;
        LDB(B1, 1, 1); STAGE(SBO(1, 0), Bt, ldb, offB, bcol, t + 3);
        BAR; WAIT_L(0); MMA(0, 1, At, B1); BAR;
        LDA(At, 1, 1); STAGE(SAO(1, 0), A, lda, offA, brow, t + 3);
        BAR; WAIT_L(0); MMA(1, 0, At, B0); BAR; SCHED;
        STAGE(SBO(1, 1), Bt, ldb, offB, bcol + 128, t + 3);
        WAIT_V(6); BAR; MMA(1, 1, At, B1); BAR;
    }
    { LDB(B0, 0, 0); LDA(At, 0, 0); STAGE(SAO(1, 1), A, lda, offA, brow + 128, nt - 1);
      BAR; WAIT_L(0); MMA(0, 0, At, B0); BAR;
      LDB(B1, 0, 1); BAR; WAIT_L(0); MMA(0, 1, At, B1); BAR;
      LDA(At, 0, 1); WAIT_V(4); BAR; WAIT_L(0); MMA(1, 0, At, B0); MMA(1, 1, At, B1); BAR; }
    { LDB(B0, 1, 0); LDA(At, 1, 0); WAIT_V(2); BAR; WAIT_L(0); MMA(0, 0, At, B0); BAR;
      LDB(B1, 1, 1); WAIT_V(0); BAR; WAIT_L(0); MMA(0, 1, At, B1); BAR;
      LDA(At, 1, 1); BAR; WAIT_L(0); MMA(1, 0, At, B0); MMA(1, 1, At, B1); BAR; }
    if (wr == 0) BAR;
#undef SA
#undef SB
#undef SAO
#undef SBO
#undef STAGE
#undef LDA
#undef LDB
#undef MMA
}

#define EPI_GEOM int tid_e = threadIdx.x; asm volatile("" : "+v"(tid_e)); const int wid = tid_e >> 6, lane = tid_e & 63, wr = wid >> 2, wc = wid & 3, fr = lane & 15, fq = lane >> 4; (void)wr; (void)wc; (void)fr; (void)fq;

__device__ __forceinline__ float dot2ones(unsigned pk, float acc) {
    return __builtin_amdgcn_fdot2_f32_bf16(__builtin_bit_cast(bf16x2_t, pk), __builtin_bit_cast(bf16x2_t, 0x3F803F80u), acc, false);
}
__device__ __forceinline__ int kperm(int i) { return (i & ~12) | ((i & 4) << 1) | ((i & 8) >> 1); }

__device__ __forceinline__ float xmax(float v) {
    auto rr = __builtin_amdgcn_permlane32_swap(__float_as_uint(v), __float_as_uint(v), false, false);
    return fmaxf(__uint_as_float(rr[0]), __uint_as_float(rr[1]));
}
__device__ __forceinline__ float xsum(float v) {
    auto rr = __builtin_amdgcn_permlane32_swap(__float_as_uint(v), __float_as_uint(v), false, false);
    return __uint_as_float(rr[0]) + __uint_as_float(rr[1]);
}
template <int DQ>
__device__ __forceinline__ void attn_unit2(unsigned char* shm, const bf16_t* __restrict__ Q0, const bf16_t* __restrict__ Q1, int ldq,
                                           const bf16_t* __restrict__ K1, int ldk1, const bf16_t* __restrict__ K2, const bf16_t* __restrict__ Vt, int S,
                                           bf16_t* __restrict__ O0, bf16_t* __restrict__ O1) {
    constexpr int KP = DQ * 2 + 16, VP = 144, VOFF = 64 * KP, BUFB = VOFF + 64 * VP, ND0 = DQ / 16;
    constexpr float THR = 6.0f;
    const int tid = threadIdx.x, lane = tid & 63, wid = tid >> 6, r32 = lane & 31, hi = lane >> 5;
    const int skey = tid >> 3, sch = tid & 7;
    const int pkey = tid >> 2, pch = tid & 3;
    const bf16_t* kg = K1 + (size_t)skey * ldk1 + sch * 8;
    const bf16_t* pg = (DQ == 96) ? (K2 + (size_t)pkey * 32 + pch * 8) : nullptr;
    const bf16_t* vg = Vt + (size_t)skey * S + sch * 8;
    const int kst = skey * KP + sch * 16, pst = pkey * KP + 128 + pch * 16, vst = VOFF + skey * VP + sch * 16;
    const int qlo = 49152 + wid * (2 * 6 * 1024) + lane * 16;
    { const bf16_t* qp0 = Q0 + (size_t)(wid * 32 + r32) * ldq + hi * 8; const bf16_t* qp1 = Q1 + (size_t)(wid * 32 + r32) * ldq + hi * 8;
      {
#pragma unroll
          for (int d0 = 0; d0 < ND0; ++d0) {
              *reinterpret_cast<bf16x8*>(shm + qlo + d0 * 1024) = *reinterpret_cast<const bf16x8*>(qp0 + d0 * 16);
              *reinterpret_cast<bf16x8*>(shm + qlo + (6 + d0) * 1024) = *reinterpret_cast<const bf16x8*>(qp1 + d0 * 16);
          }
      } }
    const int kfo = kperm(r32) * KP + hi * 16;
    const int vfo = VOFF + r32 * VP + hi * 16;
    const int NT = S / 64;
    u32x4 kreg, preg, vreg;
    kreg = *reinterpret_cast<const u32x4*>(kg); vreg = *reinterpret_cast<const u32x4*>(vg);
    if (DQ == 96) { if (tid < 256) preg = *reinterpret_cast<const u32x4*>(pg); }
    __syncthreads();
    *reinterpret_cast<u32x4*>(shm + kst) = kreg; *reinterpret_cast<u32x4*>(shm + vst) = vreg;
    if (DQ == 96) { if (tid < 256) *reinterpret_cast<u32x4*>(shm + pst) = preg; }
    __syncthreads();
    float m_run[2] = {0.f, 0.f}, l_run[2] = {0.f, 0.f};
    f32x16 zc;
#pragma unroll
    for (int r = 0; r < 16; ++r) zc[r] = 0.f;
    f32x16 o[2][2];
#pragma unroll
    for (int sb = 0; sb < 2; ++sb)
#pragma unroll
        for (int r = 0; r < 16; ++r) { o[sb][0][r] = 0.f; o[sb][1][r] = 0.f; }
    for (int t = 0; t < NT; ++t) {
        const unsigned char* buf = shm + (t & 1) * BUFB;
        if (t + 1 < NT) {
            kreg = *reinterpret_cast<const u32x4*>(kg + (size_t)(t + 1) * 64 * ldk1);
            vreg = *reinterpret_cast<const u32x4*>(vg + (t + 1) * 64);
            if (DQ == 96) { if (tid < 256) preg = *reinterpret_cast<const u32x4*>(pg + (size_t)(t + 1) * 64 * 32); }
        }
        const bool first = (t == 0);
        if (DQ == 64) {
            f32x16 p[2][2];
            {
                bf16x8 kf[8], qa[4], qb[4];
#pragma unroll
                for (int d0 = 0; d0 < 4; ++d0) {
                    kf[2 * d0] = *reinterpret_cast<const bf16x8*>(buf + kfo + d0 * 32);
                    kf[2 * d0 + 1] = *reinterpret_cast<const bf16x8*>(buf + kfo + 32 * KP + d0 * 32);
                    qa[d0] = *reinterpret_cast<const bf16x8*>(shm + qlo + d0 * 1024);
                    qb[d0] = *reinterpret_cast<const bf16x8*>(shm + qlo + (6 + d0) * 1024);
                }
                __builtin_amdgcn_sched_barrier(0);
                p[0][0] = __builtin_amdgcn_mfma_f32_32x32x16_bf16(kf[0], qa[0], zc, 0, 0, 0);
                p[0][1] = __builtin_amdgcn_mfma_f32_32x32x16_bf16(kf[1], qa[0], zc, 0, 0, 0);
                p[1][0] = __builtin_amdgcn_mfma_f32_32x32x16_bf16(kf[0], qb[0], zc, 0, 0, 0);
                p[1][1] = __builtin_amdgcn_mfma_f32_32x32x16_bf16(kf[1], qb[0], zc, 0, 0, 0);
#pragma unroll
                for (int d0 = 1; d0 < 4; ++d0) {
                    p[0][0] = __builtin_amdgcn_mfma_f32_32x32x16_bf16(kf[2 * d0], qa[d0], p[0][0], 0, 0, 0);
                    p[0][1] = __builtin_amdgcn_mfma_f32_32x32x16_bf16(kf[2 * d0 + 1], qa[d0], p[0][1], 0, 0, 0);
                    p[1][0] = __builtin_amdgcn_mfma_f32_32x32x16_bf16(kf[2 * d0], qb[d0], p[1][0], 0, 0, 0);
                    p[1][1] = __builtin_amdgcn_mfma_f32_32x32x16_bf16(kf[2 * d0 + 1], qb[d0], p[1][1], 0, 0, 0);
                }
                __builtin_amdgcn_sched_barrier(0);
            }
            bf16x8 vf[8];
#pragma unroll
            for (int ks = 0; ks < 4; ++ks) {
                vf[2 * ks] = *reinterpret_cast<const bf16x8*>(buf + vfo + ks * 32);
                vf[2 * ks + 1] = *reinterpret_cast<const bf16x8*>(buf + vfo + 32 * VP + ks * 32);
            }
            __builtin_amdgcn_sched_barrier(0);
            float rm[2];
#pragma unroll
            for (int sb = 0; sb < 2; ++sb) {
                const f32x16& p0 = p[sb][0]; const f32x16& p1 = p[sb][1];
                float a0 = __builtin_fmaxf(__builtin_fmaxf(p0[0], p0[1]), p1[0]), a1 = __builtin_fmaxf(__builtin_fmaxf(p0[2], p0[3]), p1[1]);
                a0 = __builtin_fmaxf(__builtin_fmaxf(a0, p1[2]), p1[3]);
#pragma unroll
                for (int r = 4; r < 16; r += 4) {
                    a0 = __builtin_fmaxf(__builtin_fmaxf(a0, p0[r]), p0[r + 1]); a1 = __builtin_fmaxf(__builtin_fmaxf(a1, p0[r + 2]), p0[r + 3]);
                    a0 = __builtin_fmaxf(__builtin_fmaxf(a0, p1[r]), p1[r + 1]); a1 = __builtin_fmaxf(__builtin_fmaxf(a1, p1[r + 2]), p1[r + 3]);
                }
                rm[sb] = xmax(__builtin_fmaxf(a0, a1));
            }
            {   const float rmc = fmaxf(rm[0], rm[1]);
                if (first || __any(rmc > THR)) {
                    const float dl = first ? rmc : fmaxf(rmc, 0.f);
                    const float al = first ? 0.f : __builtin_amdgcn_exp2f(-dl);
                    m_run[0] += dl; l_run[0] *= al; l_run[1] *= al;
#pragma unroll
                    for (int r = 0; r < 16; ++r) { zc[r] -= dl;
                        o[0][0][r] *= al; o[0][1][r] *= al; o[1][0][r] *= al; o[1][1][r] *= al;
                        p[0][0][r] -= dl; p[0][1][r] -= dl; p[1][0][r] -= dl; p[1][1][r] -= dl; }
                }
            }
#define SM_STEP(SB, PW) do { f32x16& p0 = p[SB][0]; f32x16& p1 = p[SB][1]; float ls0 = 0.f, ls1 = 0.f; \
                _Pragma("unroll") for (int r = 0; r < 16; ++r) { p0[r] = __builtin_amdgcn_exp2f(p0[r]); p1[r] = __builtin_amdgcn_exp2f(p1[r]); } \
                PW[0] = (u32x4){cvtpk(p0[0], p0[1]), cvtpk(p0[2], p0[3]), cvtpk(p0[4], p0[5]), cvtpk(p0[6], p0[7])}; \
                PW[1] = (u32x4){cvtpk(p0[8], p0[9]), cvtpk(p0[10], p0[11]), cvtpk(p0[12], p0[13]), cvtpk(p0[14], p0[15])}; \
                PW[2] = (u32x4){cvtpk(p1[0], p1[1]), cvtpk(p1[2], p1[3]), cvtpk(p1[4], p1[5]), cvtpk(p1[6], p1[7])}; \
                PW[3] = (u32x4){cvtpk(p1[8], p1[9]), cvtpk(p1[10], p1[11]), cvtpk(p1[12], p1[13]), cvtpk(p1[14], p1[15])}; \
                _Pragma("unroll") for (int k = 0; k < 4; ++k) { ls0 = dot2ones(PW[k][0], ls0); ls1 = dot2ones(PW[k][1], ls1); ls0 = dot2ones(PW[k][2], ls0); ls1 = dot2ones(PW[k][3], ls1); } \
                l_run[SB] += ls0 + ls1; } while (0)
            u32x4 pwa[4], pwb[4];
            SM_STEP(0, pwa);
            __builtin_amdgcn_sched_barrier(0);
#pragma unroll
            for (int ks = 0; ks < 4; ++ks) {
                const bf16x8 pb = __builtin_bit_cast(bf16x8, pwa[ks]);
                o[0][0] = __builtin_amdgcn_mfma_f32_32x32x16_bf16(vf[2 * ks], pb, o[0][0], 0, 0, 0);
                o[0][1] = __builtin_amdgcn_mfma_f32_32x32x16_bf16(vf[2 * ks + 1], pb, o[0][1], 0, 0, 0);
            }
            SM_STEP(1, pwb);
#pragma unroll
            for (int g = 0; g < 8; ++g) { __builtin_amdgcn_sched_group_barrier(0x008, 1, 0); __builtin_amdgcn_sched_group_barrier(0x002 | 0x400, 14, 0); }
            __builtin_amdgcn_sched_barrier(0);
#undef SM_STEP
#pragma unroll
            for (int ks = 0; ks < 4; ++ks) {
                const bf16x8 pb = __builtin_bit_cast(bf16x8, pwb[ks]);
                o[1][0] = __builtin_amdgcn_mfma_f32_32x32x16_bf16(vf[2 * ks], pb, o[1][0], 0, 0, 0);
                o[1][1] = __builtin_amdgcn_mfma_f32_32x32x16_bf16(vf[2 * ks + 1], pb, o[1][1], 0, 0, 0);
            }
            __builtin_amdgcn_sched_barrier(0);
        } else {
#define QK_STEP(SB, P0, P1) do { \
            _Pragma("unroll") for (int kh = 0; kh < 2; ++kh) { \
                bf16x8 kf[6]; \
                _Pragma("unroll") for (int dd = 0; dd < 3; ++dd) { \
                    kf[2 * dd] = *reinterpret_cast<const bf16x8*>(buf + kfo + (kh * 3 + dd) * 32); \
                    kf[2 * dd + 1] = *reinterpret_cast<const bf16x8*>(buf + kfo + 32 * KP + (kh * 3 + dd) * 32); } \
                __builtin_amdgcn_sched_barrier(0); \
                _Pragma("unroll") for (int dd = 0; dd < 3; ++dd) { \
                    const bf16x8 qf = *reinterpret_cast<const bf16x8*>(shm + qlo + ((SB) * 6 + kh * 3 + dd) * 1024); \
                    if (kh == 0 && dd == 0) { \
                        P0 = __builtin_amdgcn_mfma_f32_32x32x16_bf16(kf[0], qf, zc, 0, 0, 0); P1 = __builtin_amdgcn_mfma_f32_32x32x16_bf16(kf[1], qf, zc, 0, 0, 0); } \
                    else { P0 = __builtin_amdgcn_mfma_f32_32x32x16_bf16(kf[2 * dd], qf, P0, 0, 0, 0); P1 = __builtin_amdgcn_mfma_f32_32x32x16_bf16(kf[2 * dd + 1], qf, P1, 0, 0, 0); } } \
                __builtin_amdgcn_sched_barrier(0); } } while (0)
#define ROWMAX_S(P0, P1, RM) do { \
            float a0 = __builtin_fmaxf(__builtin_fmaxf(P0[0], P0[1]), P1[0]), a1 = __builtin_fmaxf(__builtin_fmaxf(P0[2], P0[3]), P1[1]); \
            a0 = __builtin_fmaxf(__builtin_fmaxf(a0, P1[2]), P1[3]); \
            _Pragma("unroll") for (int r = 4; r < 16; r += 4) { \
                a0 = __builtin_fmaxf(__builtin_fmaxf(a0, P0[r]), P0[r + 1]); a1 = __builtin_fmaxf(__builtin_fmaxf(a1, P0[r + 2]), P0[r + 3]); \
                a0 = __builtin_fmaxf(__builtin_fmaxf(a0, P1[r]), P1[r + 1]); a1 = __builtin_fmaxf(__builtin_fmaxf(a1, P1[r + 2]), P1[r + 3]); } \
            RM = xmax(__builtin_fmaxf(a0, a1));   } while (0)
#define SM_STEP(SB, P0, P1, PW) do { float ls0 = 0.f, ls1 = 0.f; \
            _Pragma("unroll") for (int r = 0; r < 16; ++r) { P0[r] = __builtin_amdgcn_exp2f(P0[r]); P1[r] = __builtin_amdgcn_exp2f(P1[r]); } \
            PW[0] = (u32x4){cvtpk(P0[0], P0[1]), cvtpk(P0[2], P0[3]), cvtpk(P0[4], P0[5]), cvtpk(P0[6], P0[7])}; \
            PW[1] = (u32x4){cvtpk(P0[8], P0[9]), cvtpk(P0[10], P0[11]), cvtpk(P0[12], P0[13]), cvtpk(P0[14], P0[15])}; \
            PW[2] = (u32x4){cvtpk(P1[0], P1[1]), cvtpk(P1[2], P1[3]), cvtpk(P1[4], P1[5]), cvtpk(P1[6], P1[7])}; \
            PW[3] = (u32x4){cvtpk(P1[8], P1[9]), cvtpk(P1[10], P1[11]), cvtpk(P1[12], P1[13]), cvtpk(P1[14], P1[15])}; \
            _Pragma("unroll") for (int k = 0; k < 4; ++k) { ls0 = dot2ones(PW[k][0], ls0); ls1 = dot2ones(PW[k][1], ls1); ls0 = dot2ones(PW[k][2], ls0); ls1 = dot2ones(PW[k][3], ls1); } \
            l_run[SB] += ls0 + ls1; } while (0)
            u32x4 pwa[4], pwb[4];
            f32x16 pa0, pa1, pb0, pb1;
#pragma unroll
            for (int kh = 0; kh < 2; ++kh) {
                bf16x8 kf[6], qa[3], qb[3];
#pragma unroll
                for (int dd = 0; dd < 3; ++dd) {
                    kf[2 * dd] = *reinterpret_cast<const bf16x8*>(buf + kfo + (kh * 3 + dd) * 32);
                    kf[2 * dd + 1] = *reinterpret_cast<const bf16x8*>(buf + kfo + 32 * KP + (kh * 3 + dd) * 32);
                    qa[dd] = *reinterpret_cast<const bf16x8*>(shm + qlo + (kh * 3 + dd) * 1024);
                    qb[dd] = *reinterpret_cast<const bf16x8*>(shm + qlo + (6 + kh * 3 + dd) * 1024);
                }
                __builtin_amdgcn_sched_barrier(0);
#pragma unroll
                for (int dd = 0; dd < 3; ++dd) {
                    if (kh == 0 && dd == 0) {
                        pa0 = __builtin_amdgcn_mfma_f32_32x32x16_bf16(kf[0], qa[0], zc, 0, 0, 0); pa1 = __builtin_amdgcn_mfma_f32_32x32x16_bf16(kf[1], qa[0], zc, 0, 0, 0);
                        pb0 = __builtin_amdgcn_mfma_f32_32x32x16_bf16(kf[0], qb[0], zc, 0, 0, 0); pb1 = __builtin_amdgcn_mfma_f32_32x32x16_bf16(kf[1], qb[0], zc, 0, 0, 0);
                    } else {
                        pa0 = __builtin_amdgcn_mfma_f32_32x32x16_bf16(kf[2 * dd], qa[dd], pa0, 0, 0, 0); pa1 = __builtin_amdgcn_mfma_f32_32x32x16_bf16(kf[2 * dd + 1], qa[dd], pa1, 0, 0, 0);
                        pb0 = __builtin_amdgcn_mfma_f32_32x32x16_bf16(kf[2 * dd], qb[dd], pb0, 0, 0, 0); pb1 = __builtin_amdgcn_mfma_f32_32x32x16_bf16(kf[2 * dd + 1], qb[dd], pb1, 0, 0, 0);
                    }
                }
                __builtin_amdgcn_sched_barrier(0);
            }
            bf16x8 vf[8];
#pragma unroll
            for (int ks = 0; ks < 4; ++ks) {
                vf[2 * ks] = *reinterpret_cast<const bf16x8*>(buf + vfo + ks * 32);
                vf[2 * ks + 1] = *reinterpret_cast<const bf16x8*>(buf + vfo + 32 * VP + ks * 32);
            }
            {
                float rma, rmb; ROWMAX_S(pa0, pa1, rma); ROWMAX_S(pb0, pb1, rmb);
                const float rmc = fmaxf(rma, rmb);
                if (first || __any(rmc > THR)) {
                    const float dl = first ? rmc : fmaxf(rmc, 0.f); const float al = first ? 0.f : __builtin_amdgcn_exp2f(-dl);
                    m_run[0] += dl; l_run[0] *= al; l_run[1] *= al;
#pragma unroll
                    for (int r = 0; r < 16; ++r) { zc[r] -= dl; o[0][0][r] *= al; o[0][1][r] *= al; o[1][0][r] *= al; o[1][1][r] *= al;
                        pa0[r] -= dl; pa1[r] -= dl; pb0[r] -= dl; pb1[r] -= dl; }
                }
            }
            SM_STEP(0, pa0, pa1, pwa);
            __builtin_amdgcn_sched_barrier(0);
#pragma unroll
            for (int ks = 0; ks < 4; ++ks) {
                const bf16x8 pb = __builtin_bit_cast(bf16x8, pwa[ks]);
                o[0][0] = __builtin_amdgcn_mfma_f32_32x32x16_bf16(vf[2 * ks], pb, o[0][0], 0, 0, 0);
                o[0][1] = __builtin_amdgcn_mfma_f32_32x32x16_bf16(vf[2 * ks + 1], pb, o[0][1], 0, 0, 0);
            }
            SM_STEP(1, pb0, pb1, pwb);
#pragma unroll
            for (int g = 0; g < 8; ++g) { __builtin_amdgcn_sched_group_barrier(0x008, 1, 0); __builtin_amdgcn_sched_group_barrier(0x002 | 0x400, 14, 0); }
            __builtin_amdgcn_sched_barrier(0);
#undef QK_STEP
#undef ROWMAX_S
#undef SM_STEP
#pragma unroll
            for (int ks = 0; ks < 4; ++ks) {
                const bf16x8 pb = __builtin_bit_cast(bf16x8, pwb[ks]);
                o[1][0] = __builtin_amdgcn_mfma_f32_32x32x16_bf16(vf[2 * ks], pb, o[1][0], 0, 0, 0);
                o[1][1] = __builtin_amdgcn_mfma_f32_32x32x16_bf16(vf[2 * ks + 1], pb, o[1][1], 0, 0, 0);
            }
            __builtin_amdgcn_sched_barrier(0);
        }
        if (t + 1 < NT) {
            unsigned char* nb = shm + ((t + 1) & 1) * BUFB;
            *reinterpret_cast<u32x4*>(nb + kst) = kreg; *reinterpret_cast<u32x4*>(nb + vst) = vreg;
            if (DQ == 96) { if (tid < 256) *reinterpret_cast<u32x4*>(nb + pst) = preg; }
        }
        __syncthreads();
    }
#pragma unroll
    for (int sb = 0; sb < 2; ++sb) {
        const float lt = xsum(l_run[sb]);
        const float inv = 1.0f / lt;
        bf16_t* op = (sb == 0 ? O0 : O1) + (size_t)(wid * 32 + r32) * DM + 4 * hi;
#pragma unroll
        for (int g = 0; g < 4; ++g) {
            *reinterpret_cast<u32x2*>(op + 8 * g) = (u32x2){cvtpk(o[sb][0][4 * g] * inv, o[sb][0][4 * g + 1] * inv), cvtpk(o[sb][0][4 * g + 2] * inv, o[sb][0][4 * g + 3] * inv)};
            *reinterpret_cast<u32x2*>(op + 32 + 8 * g) = (u32x2){cvtpk(o[sb][1][4 * g] * inv, o[sb][1][4 * g + 1] * inv), cvtpk(o[sb][1][4 * g + 2] * inv, o[sb][1][4 * g + 3] * inv)};
        }
    }
}

template <int MODE>
__device__ __forceinline__ void conv_weight(const float* __restrict__ W, int K, int N, bf16_t* __restrict__ dst, int ldb,
                                            const float* __restrict__ gA, const float* __restrict__ gB, int gtid, int gthreads) {
    const int total = N * (K / 8);
    for (int i = gtid; i < total; i += gthreads) {
        const int kq = i / N, n = i - kq * N, k0 = kq * 8;
        float v[8];
#pragma unroll
        for (int j = 0; j < 8; ++j) {
            float w = W[(size_t)(k0 + j) * N + n];
            if (MODE == 1) w *= gA[k0 + j];
            if (MODE == 2) w *= (k0 + j < 512) ? gA[k0 + j] : gB[k0 + j - 512];
            v[j] = w;
        }
        int row = n;
        if (MODE == 3) row = (n >> 7) * 256 + (n & 127);
        if (MODE == 4) row = (n >> 7) * 256 + 128 + (n & 127);
        *reinterpret_cast<u32x4*>(dst + (size_t)row * ldb + k0) = (u32x4){cvtpk(v[0], v[1]), cvtpk(v[2], v[3]), cvtpk(v[4], v[5]), cvtpk(v[6], v[7])};
    }
}

#define LAS __attribute__((address_space(3)))
#define XB_TMO      128
#define XB_XCNT(j)  (256  + 64 * (j))
#define XB_XSUB(j)  (1280 + 64 * (j))
#define XB_XGEN(j)  (2304 + 64 * (j))
#define XB_TOP      3328
#define XB_TOPGEN   3392
#define XCD_BAR_WORDS 3456
#define XB_SPIN_CAP (1u << 18)
__device__ __forceinline__ unsigned xb_ld(unsigned* p)              { return __hip_atomic_load(p, __ATOMIC_RELAXED, __HIP_MEMORY_SCOPE_AGENT); }
__device__ __forceinline__ unsigned xb_add(unsigned* p, unsigned v) { return __hip_atomic_fetch_add(p, v, __ATOMIC_RELAXED, __HIP_MEMORY_SCOPE_AGENT); }
__device__ __forceinline__ unsigned xb_xcc_id() { return (unsigned)__builtin_amdgcn_s_getreg((3 << 11) | 20) & 0xFu; }
#define XB_SPIN(cond, bar) do { unsigned _sp = 0; while (cond) { __builtin_amdgcn_s_sleep(1); \
    if ((++_sp & 255u) == 0u) { if (xb_ld(&(bar)[XB_TMO])) break; if (_sp > XB_SPIN_CAP) { atomicAdd(&(bar)[XB_TMO], 1u); break; } } } } while (0)
__device__ __forceinline__ void xcd_barrier_complete(unsigned* bar, unsigned x, unsigned& nloc, unsigned& nx) {
    const unsigned G = gridDim.x * gridDim.y * gridDim.z;
    unsigned sum, cnt, mine, sp = 0u;
    for (;;) {
        sum = 0u; cnt = 0u; mine = 0u;
#pragma unroll
        for (unsigned j = 0; j < 16; ++j) { const unsigned c = xb_ld(&bar[XB_XCNT(j)]); sum += c; cnt += (c > 0u) ? 1u : 0u; mine = (j == x) ? c : mine; }
        if (sum == G) break;
        __builtin_amdgcn_s_sleep(1);
        if ((++sp & 255u) == 0u) { if (xb_ld(&bar[XB_TMO])) break; if (sp > XB_SPIN_CAP) { atomicAdd(&bar[XB_TMO], 1u); break; } }
    }
    nloc = mine > 0u ? mine : 1u; nx = cnt > 0u ? cnt : 1u;
}
__device__ __forceinline__ void xcd_barrier(unsigned* bar, unsigned x, volatile LAS unsigned* st, bool leader) {
    asm volatile("s_waitcnt vmcnt(0)" ::: "memory");
    __syncthreads();
    if (leader) {
        __builtin_amdgcn_s_waitcnt(0);
        unsigned nloc = st[0], nx = st[1];
        if (nloc == 0u) { xcd_barrier_complete(bar, x, nloc, nx); st[0] = nloc; st[1] = nx; }
        const unsigned old = xb_add(&bar[XB_XSUB(x)], 1u);
        const unsigned gen = old / nloc;
        if (old + 1u == (gen + 1u) * nloc) {
            __builtin_amdgcn_fence(__ATOMIC_RELEASE, "agent");
            asm volatile("s_waitcnt vmcnt(0)" ::: "memory");
            const unsigned og = xb_add(&bar[XB_TOP], 1u);
            const unsigned tg = og / nx;
            if (og + 1u == (tg + 1u) * nx) xb_add(&bar[XB_TOPGEN], 1u);
            else XB_SPIN(xb_ld(&bar[XB_TOPGEN]) == tg, bar);
            __builtin_amdgcn_fence(__ATOMIC_ACQUIRE, "agent");
            xb_add(&bar[XB_XGEN(x)], 1u);
            asm volatile("s_waitcnt vmcnt(0)" ::: "memory");
        } else {
            XB_SPIN(xb_ld(&bar[XB_XGEN(x)]) == gen, bar);
            __builtin_amdgcn_fence(__ATOMIC_ACQUIRE, "agent");
            asm volatile("s_waitcnt vmcnt(0)" ::: "memory");
        }
    }
    __syncthreads();
}

__global__ void __launch_bounds__(512) fwd_kernel(Params p) {
    extern __shared__ __attribute__((aligned(16))) unsigned char lds[];
    cg::grid_group grid = cg::this_grid();
    const int tid = threadIdx.x, lane = tid & 63, wv = tid >> 6;
    const int G = gridDim.x, bx = blockIdx.x;
    const int vcu = ((G & 7) == 0) ? (bx % 8) * (G / 8) + bx / 8 : bx;
    unsigned char* ws = p.ws;
    const float* xp = p.in[0]; const float* xs = p.in[1];
    bf16_t* W1t = (bf16_t*)(ws + WS_W1T); bf16_t* Wuqt = (bf16_t*)(ws + WS_WUQT); bf16_t* Wukvt = (bf16_t*)(ws + WS_WUKVT);
    bf16_t* Woutt = (bf16_t*)(ws + WS_WOUTT); bf16_t* Wgut = (bf16_t*)(ws + WS_WGUT); bf16_t* Wdnt = (bf16_t*)(ws + WS_WDNT);
    float* mod = (float*)(ws + WS_MOD);
    float* cosA = (float*)(ws + WS_COSA); float* sinA = (float*)(ws + WS_SINA); float* cosB = (float*)(ws + WS_COSB); float* sinB = (float*)(ws + WS_SINB);
    float* rsq = (float*)(ws + WS_RSQ); float* rskv = (float*)(ws + WS_RSKV);
    bf16_t* U = (bf16_t*)(ws + WS_U); bf16_t* H = (bf16_t*)(ws + WS_H); bf16_t* Ob = (bf16_t*)(ws + WS_O);
    bf16_t* Qa = (bf16_t*)(ws + WS_QA); bf16_t* Ka = (bf16_t*)(ws + WS_KA); bf16_t* Vta = (bf16_t*)(ws + WS_VTA);
    bf16_t* Qm = (bf16_t*)(ws + WS_QM); bf16_t* Kn = (bf16_t*)(ws + WS_KN); bf16_t* Kpe = (bf16_t*)(ws + WS_KPE); bf16_t* Vtm = (bf16_t*)(ws + WS_VTM);
    bf16_t* F = (bf16_t*)(ws + WS_F);
    float* out = p.out;
    const int lo = p.lo, hi_ = p.hi;
#ifndef PH_MASK
#define PH_MASK 0xFFF
#endif
#define IN(k) (((PH_MASK >> (k)) & 1) && lo <= (k) && (k) < hi_)
#define SEAM(k) do { if (IN(k) && IN((k) + 1)) { if ((k) == 0) grid.sync(); else xcd_barrier(xbar, xcc, xst, tid == 0); } } while (0)
    unsigned* const xbar = (unsigned*)(p.ws + WS_BAR);
    volatile LAS unsigned* const xst = (volatile LAS unsigned*)((LAS unsigned char*)lds + LDS_XST);
    const unsigned xcc = xb_xcc_id();
    if (tid == 0) { xst[0] = 0u; xst[1] = 0u; (void)xb_add(&xbar[XB_XCNT(xcc)], 1u); }
    __syncthreads();

    if (IN(0)) {
        float* s_c = (float*)lds;
        float* red = (float*)(lds + 65536);
        const float* cpr = p.in[2]; const float* csm = p.in[3]; const float* w_ada = p.in[4]; const float* b_ada = p.in[5];
        for (int cb = bx; cb < 192; cb += G) {
            for (int i = tid; i < 16 * 1024; i += 512) {
                const int b = i >> 10, k = i & 1023; const float c = (b < 8) ? cpr[b * 1024 + k] : csm[(b - 8) * 1024 + k];
                s_c[i] = c / (1.0f + __expf(-c));
            }
            __syncthreads();
            const int kgp = tid >> 5, cl = tid & 31, col = cb * 32 + cl;
            float a[16];
#pragma unroll
            for (int b = 0; b < 16; ++b) a[b] = 0.f;
            for (int k = kgp * 64; k < kgp * 64 + 64; ++k) {
                const float w = w_ada[(size_t)k * 6144 + col];
#pragma unroll
                for (int b = 0; b < 16; ++b) a[b] += s_c[b * 1024 + k] * w;
            }
#pragma unroll
            for (int b = 0; b < 16; ++b) red[(kgp * 16 + b) * 32 + cl] = a[b];
            __syncthreads();
            { const int b = tid >> 5; float s = 0.f;
#pragma unroll
              for (int k2 = 0; k2 < 16; ++k2) s += red[(k2 * 16 + b) * 32 + cl];
              mod[b * 6144 + col] = s + b_ada[col]; }
            __syncthreads();
        }
        const int gtid = bx * 512 + tid, gth = G * 512;
        for (int i = gtid; i < 8192 * 48; i += gth) {
            const int s = i / 48, j = i - s * 48;
            int ii, n; if (j < 32) { ii = j; n = 16; } else { ii = j - 32; n = 8; }
            const int pos = (ii < n) ? (s >> 6) : (s & 63); const int fi = (ii < n) ? ii : ii - n;
            const float inv = exp2f(-((float)fi / (float)n) * 13.287712379549449f);
            const float ang = (float)pos * inv;
            const double rev = (double)ang * 0.15915494309189535; const float fr_ = (float)(rev - floor(rev));
            const float cv = __builtin_amdgcn_cosf(fr_), sv = __builtin_amdgcn_sinf(fr_);
            if (j < 32) { cosA[s * 32 + ii] = cv; sinA[s * 32 + ii] = sv; } else { cosB[s * 16 + ii] = cv; sinB[s * 16 + ii] = sv; }
        }
        conv_weight<0>(p.in[6], 1024, 1184, W1t, 1024, nullptr, nullptr, gtid, gth);
        for (int i = gtid; i < 96 * 1024 / 8; i += gth) *reinterpret_cast<u32x4*>(W1t + (size_t)1184 * 1024 + (size_t)i * 8) = (u32x4){0u, 0u, 0u, 0u};
        conv_weight<1>(p.in[10], 256, 768, Wuqt, 256, p.in[9], nullptr, gtid, gth);
        conv_weight<1>(p.in[12], 128, 1024, Wukvt, 256, p.in[11], nullptr, gtid, gth);
        for (int i = gtid; i < 1024 * 16; i += gth) { const int r = i >> 4, c = i & 15; *reinterpret_cast<u32x4*>(Wukvt + (size_t)r * 256 + 128 + c * 8) = (u32x4){0u, 0u, 0u, 0u}; }
        conv_weight<2>(p.in[15], 1024, 1024, Woutt, 1024, p.in[13], p.in[14], gtid, gth);
        conv_weight<3>(p.in[18], 1024, 2816, Wgut, 1024, nullptr, nullptr, gtid, gth);
        conv_weight<4>(p.in[19], 1024, 2816, Wgut, 1024, nullptr, nullptr, gtid, gth);
        conv_weight<0>(p.in[20], 2816, 1024, Wdnt, 2816, nullptr, nullptr, gtid, gth);
    }
    SEAM(0);

    if (IN(1)) {
        constexpr int NR = 4;
        for (int t0 = bx * 8 + wv; t0 < T; t0 += NR * G * 8) {
            f32x4 v[NR][4];
#pragma unroll
            for (int rr = 0; rr < NR; ++rr) {
                const int t = t0 + rr * G * 8; const float* xr = xrow(xp, xs, t < T ? t : t0);
#pragma unroll
                for (int c = 0; c < 4; ++c) v[rr][c] = *reinterpret_cast<const f32x4*>(xr + c * 256 + lane * 4);
            }
#pragma unroll
            for (int rr = 0; rr < NR; ++rr) {
                const int t = t0 + rr * G * 8;
                float s = 0.f;
#pragma unroll
                for (int c = 0; c < 4; ++c) s += (v[rr][c][0] + v[rr][c][1]) + (v[rr][c][2] + v[rr][c][3]);
                const float mean = wave_sum(s) * (1.0f / 1024.0f);
                float q = 0.f;
#pragma unroll
                for (int c = 0; c < 4; ++c) { v[rr][c] = v[rr][c] - mean; q += (v[rr][c][0] * v[rr][c][0] + v[rr][c][1] * v[rr][c][1]) + (v[rr][c][2] * v[rr][c][2] + v[rr][c][3] * v[rr][c][3]); }
                const float rstd = rsqrtf(wave_sum(q) * (1.0f / 1024.0f) + EPS);
                if (t < T) {
                    int b, S, tok0; tokinfo(t, b, S, tok0);
                    const float* md = mod + b * 6144;
#pragma unroll
                    for (int c = 0; c < 4; ++c) {
                        const int col = c * 256 + lane * 4;
                        const f32x4 sh = *reinterpret_cast<const f32x4*>(md + col), sc = *reinterpret_cast<const f32x4*>(md + 1024 + col);
                        const f32x4 y = v[rr][c] * rstd * (sc + 1.0f) + sh;
                        *reinterpret_cast<u32x2*>(U + (size_t)t * DM + col) = (u32x2){cvtpk(y[0], y[1]), cvtpk(y[2], y[3])};
                    }
                }
            }
        }
    }
    SEAM(1);

    if (IN(2)) {
        int pm, pn;
        for (int i = 0; tile_next(i, G, bx, NMT, 5, pm, pn); ++i) {
            f32x4 acc[2][2][4][2];
            const int brow = pm * 256, bcol = pn * 256;
            int b, S, tok0; tokinfo(brow, b, S, tok0);
            if (pn == 2) {
                gemm_core<false>(lds, U, DM, W1t, DM, 16, brow, bcol, acc);
                EPI_GEOM
#pragma unroll
                for (int ai = 0; ai < 2; ++ai)
#pragma unroll
                    for (int m = 0; m < 4; ++m) {
                        asm volatile("" ::: "memory"); const int row = brow + ai * 128 + wr * 64 + m * 16 + fq * 4;
#pragma unroll
                        for (int bj = 0; bj < 2; ++bj)
#pragma unroll
                            for (int n = 0; n < 2; ++n) {
                                const int col = bcol + bj * 128 + wc * 32 + n * 16 + fr; const f32x4 v = acc[ai][bj][m][n];
                                if (bj == 1) {
                                    const size_t off = (size_t)tok0 * 128 + (size_t)(col - 640) * S + (row - tok0);
                                    *reinterpret_cast<u32x2*>(Vta + off) = (u32x2){cvtpk(v[0], v[1]), cvtpk(v[2], v[3])};
                                } else {
#pragma unroll
                                    for (int j = 0; j < 4; ++j) H[(size_t)(row + j) * HP + col] = f2bf(v[j]);
                                }
                            }
                    }
            } else {
                gemm_core<true>(lds, U, DM, W1t, DM, 16, brow, bcol, acc);
                EPI_GEOM
#pragma unroll
                for (int ai = 0; ai < 2; ++ai)
#pragma unroll
                    for (int m = 0; m < 4; ++m) {
                        asm volatile("" ::: "memory"); const int row = brow + ai * 128 + wr * 64 + m * 16 + fr;
#pragma unroll
                        for (int bj = 0; bj < 2; ++bj)
#pragma unroll
                            for (int n = 0; n < 2; ++n) {
                                const int c0 = bcol + bj * 128 + wc * 32 + n * 16 + fq * 4; const f32x4 v = acc[ai][bj][m][n];
                                *reinterpret_cast<u32x2*>(H + (size_t)row * HP + c0) = (u32x2){cvtpk(v[0], v[1]), cvtpk(v[2], v[3])};
                            }
                    }
                if (pn >= 3) {
                    float* part = (float*)(ws + (pn == 3 ? WS_PQ : WS_PKV));
#pragma unroll
                    for (int ai = 0; ai < 2; ++ai)
#pragma unroll
                        for (int m = 0; m < 4; ++m) {
                            const int row = brow + ai * 128 + wr * 64 + m * 16 + fr;
                            float sq = 0.f;
#pragma unroll
                            for (int n = 0; n < 2; ++n) {
                                const f32x4 v0 = acc[ai][0][m][n], v1 = acc[ai][1][m][n];
                                sq += (v0[0] * v0[0] + v0[1] * v0[1]) + (v0[2] * v0[2] + v0[3] * v0[3]);
                                if (pn == 3) sq += (v1[0] * v1[0] + v1[1] * v1[1]) + (v1[2] * v1[2] + v1[3] * v1[3]);
                            }
                            sq += __shfl_xor(sq, 16); sq += __shfl_xor(sq, 32);
                            part[(size_t)row * 4 + wc] = sq;
                        }
                }
            }
        }
    }
    SEAM(2);

    if (IN(3)) {
        const float* gq = p.in[7]; const float* gk = p.in[8];
        for (int t = bx * 8 + wv; t < T; t += G * 8) {
            int b, S, tok0; tokinfo(t, b, S, tok0); const int s = t - tok0;
            const bf16_t* hr = H + (size_t)t * HP;
            if (lane < 40) {
                const int hh = lane >> 2, c = lane & 3; const bool isq = hh < 8;
                const u32x4 a1 = *reinterpret_cast<const u32x4*>(hr + hh * 64 + c * 8), a2 = *reinterpret_cast<const u32x4*>(hr + hh * 64 + 32 + c * 8);
                float x1[8], x2[8]; float ss = 0.f;
#pragma unroll
                for (int e = 0; e < 4; ++e) {
                    x1[2 * e] = __uint_as_float(a1[e] << 16); x1[2 * e + 1] = __uint_as_float(a1[e] & 0xffff0000u);
                    x2[2 * e] = __uint_as_float(a2[e] << 16); x2[2 * e + 1] = __uint_as_float(a2[e] & 0xffff0000u);
                }
#pragma unroll
                for (int e = 0; e < 8; ++e) ss += x1[e] * x1[e] + x2[e] * x2[e];
                ss += __shfl_xor(ss, 1); ss += __shfl_xor(ss, 2);
                const float rstd = rsqrtf(ss * (1.0f / 64.0f) + EPS);
                const float* g = isq ? gq : gk; const float scl = isq ? C2A : 1.0f;
                float o1[8], o2[8];
#pragma unroll
                for (int e = 0; e < 8; ++e) {
                    const int d1 = c * 8 + e;
                    const float a = x1[e] * rstd * g[d1], bb = x2[e] * rstd * g[d1 + 32];
                    const float cs = cosA[s * 32 + d1], sn = sinA[s * 32 + d1];
                    o1[e] = (a * cs - bb * sn) * scl; o2[e] = (a * sn + bb * cs) * scl;
                }
                bf16_t* dst = isq ? (Qa + (size_t)t * 512 + hh * 64 + c * 8) : (Ka + (size_t)t * 128 + (hh - 8) * 64 + c * 8);
                *reinterpret_cast<u32x4*>(dst) = (u32x4){cvtpk(o1[0], o1[1]), cvtpk(o1[2], o1[3]), cvtpk(o1[4], o1[5]), cvtpk(o1[6], o1[7])};
                *reinterpret_cast<u32x4*>(dst + 32) = (u32x4){cvtpk(o2[0], o2[1]), cvtpk(o2[2], o2[3]), cvtpk(o2[4], o2[5]), cvtpk(o2[6], o2[7])};
            }
            if (lane < 2) {
                const u32x4 a1 = *reinterpret_cast<const u32x4*>(hr + 1152 + lane * 8), a2 = *reinterpret_cast<const u32x4*>(hr + 1152 + 16 + lane * 8);
                float o1[8], o2[8];
#pragma unroll
                for (int e = 0; e < 4; ++e) {
#pragma unroll
                    for (int h2 = 0; h2 < 2; ++h2) {
                        const int ee = 2 * e + h2, i = lane * 8 + ee;
                        const float a = h2 ? __uint_as_float(a1[e] & 0xffff0000u) : __uint_as_float(a1[e] << 16);
                        const float bb = h2 ? __uint_as_float(a2[e] & 0xffff0000u) : __uint_as_float(a2[e] << 16);
                        const float cs = cosB[s * 16 + i], sn = sinB[s * 16 + i];
                        o1[ee] = a * cs - bb * sn; o2[ee] = a * sn + bb * cs;
                    }
                }
                bf16_t* dst = Kpe + (size_t)t * 32 + lane * 8;
                *reinterpret_cast<u32x4*>(dst) = (u32x4){cvtpk(o1[0], o1[1]), cvtpk(o1[2], o1[3]), cvtpk(o1[4], o1[5]), cvtpk(o1[6], o1[7])};
                *reinterpret_cast<u32x4*>(dst + 16) = (u32x4){cvtpk(o2[0], o2[1]), cvtpk(o2[2], o2[3]), cvtpk(o2[4], o2[5]), cvtpk(o2[6], o2[7])};
            }
        }
    }

    if (IN(4)) {
        int pm, pn;
        for (int i = 0; tile_next(i, G, bx, NMT, 7, pm, pn); ++i) {
            f32x4 acc[2][2][4][2];
            const int brow = pm * 256;
            const bool isq = pn < 3;
            const bf16_t* A = H + (isq ? 768 : 1024);
            const bf16_t* Bt = isq ? Wuqt : Wukvt;
            const int bcol = isq ? pn * 256 : (pn - 3) * 256;
            int b, S, tok0; tokinfo(brow, b, S, tok0);
            if (isq) {
                gemm_core<true>(lds, A, HP, Bt, 256, 4, brow, bcol, acc);
                EPI_GEOM
#pragma unroll
                for (int ai = 0; ai < 2; ++ai)
#pragma unroll
                    for (int m = 0; m < 4; ++m) {
                        asm volatile("" ::: "memory"); const int row = brow + ai * 128 + wr * 64 + m * 16 + fr;
                        const f32x4 pq = *reinterpret_cast<const f32x4*>((const float*)(ws + WS_PQ) + (size_t)row * 4);
                        const float rs = rsqrtf(((pq[0] + pq[1]) + (pq[2] + pq[3])) * (1.0f / 256.0f) + EPS) * C2M; const int sp = row - tok0;
                        const f32x4 cs = *reinterpret_cast<const f32x4*>(cosB + sp * 16 + fq * 4), sn = *reinterpret_cast<const f32x4*>(sinB + sp * 16 + fq * 4);
#pragma unroll
                        for (int bj = 0; bj < 2; ++bj) {
                            const int g32 = pn * 8 + bj * 4 + wc; const bool isrope = (g32 % 3) == 2; const int colb = g32 * 32 + fq * 4;
                            f32x4 v0 = acc[ai][bj][m][0] * rs, v1 = acc[ai][bj][m][1] * rs;
                            if (isrope) { const f32x4 ra = v0 * cs - v1 * sn, rb = v0 * sn + v1 * cs; v0 = ra; v1 = rb; }
                            *reinterpret_cast<u32x2*>(Qm + (size_t)row * 768 + colb) = (u32x2){cvtpk(v0[0], v0[1]), cvtpk(v0[2], v0[3])};
                            *reinterpret_cast<u32x2*>(Qm + (size_t)row * 768 + colb + 16) = (u32x2){cvtpk(v1[0], v1[1]), cvtpk(v1[2], v1[3])};
                        }
                    }
            } else {
                gemm_core<false>(lds, A, HP, Bt, 256, 4, brow, bcol, acc);
                EPI_GEOM
#pragma unroll
                for (int ai = 0; ai < 2; ++ai)
#pragma unroll
                    for (int m = 0; m < 4; ++m) {
                        asm volatile("" ::: "memory"); const int row = brow + ai * 128 + wr * 64 + m * 16 + fq * 4;
                        float rs[4];
#pragma unroll
                        for (int j = 0; j < 4; ++j) { const f32x4 pk = *reinterpret_cast<const f32x4*>((const float*)(ws + WS_PKV) + (size_t)(row + j) * 4); rs[j] = rsqrtf(((pk[0] + pk[1]) + (pk[2] + pk[3])) * (1.0f / 128.0f) + EPS); }
#pragma unroll
                        for (int bj = 0; bj < 2; ++bj) {
                            const int head = (pn - 3) * 2 + bj;
#pragma unroll
                            for (int n = 0; n < 2; ++n) {
                                const int within = wc * 32 + n * 16 + fr; const f32x4 v = acc[ai][bj][m][n];
                                if (wc < 2) {
#pragma unroll
                                    for (int j = 0; j < 4; ++j) Kn[(size_t)(row + j) * 512 + head * 64 + within] = f2bf(v[j] * rs[j]);
                                } else {
                                    const size_t off = (size_t)tok0 * 512 + (size_t)(head * 64 + within - 64) * S + (row - tok0);
                                    *reinterpret_cast<u32x2*>(Vtm + off) = (u32x2){cvtpk(v[0] * rs[0], v[1] * rs[1]), cvtpk(v[2] * rs[2], v[3] * rs[3])};
                                }
                            }
                        }
                    }
            }
        }
    }
    SEAM(4);

    if (IN(5)) {
#ifndef NO_MLA
        for (int u = vcu; u < 1280; u += G) {
            const bool smp = u < 1024; const int idx = smp ? u : u - 1024;
            const int S = smp ? 8192 : 2048;
            const int nqb = S / 512, qb = idx % nqb, head = (idx / nqb) & 7, bl = idx / (nqb * 8);
            const int tok0 = smp ? TP + bl * 8192 : bl * 2048, q0 = tok0 + qb * 512;
            const bf16_t* q = Qm + (size_t)q0 * 768 + head * 96; bf16_t* o = Ob + (size_t)q0 * DM + 512 + head * 64;
            attn_unit2<96>(lds, q, q + (size_t)256 * 768, 768, Kn + (size_t)tok0 * 512 + head * 64, 512, Kpe + (size_t)tok0 * 32,
                           Vtm + (size_t)tok0 * 512 + (size_t)head * 64 * S, S, o, o + (size_t)256 * DM);
        }
#endif
#ifndef NO_GQA
        for (int u = vcu; u < 1280; u += G) {
            const bool smp = u < 1024; const int idx = smp ? u : u - 1024;
            const int S = smp ? 8192 : 2048;
            const int nqb = S / 256, qb = idx % nqb, hp = (idx / nqb) & 3, bl = idx / (nqb * 4);
            const int kvh = hp >> 1, head = hp * 2;
            const int tok0 = smp ? TP + bl * 8192 : bl * 2048, q0 = tok0 + qb * 256;
            const bf16_t* q = Qa + (size_t)q0 * 512 + head * 64; bf16_t* o = Ob + (size_t)q0 * DM + head * 64;
            attn_unit2<64>(lds, q, q + 64, 512, Ka + (size_t)tok0 * 128 + kvh * 64, 128, nullptr,
                           Vta + (size_t)tok0 * 128 + (size_t)kvh * 64 * S, S, o, o + 64);
        }
#endif
    }
    SEAM(5);

    if (IN(6)) {
        constexpr int NR = 4;
        for (int t0 = bx * 8 + wv; t0 < T; t0 += NR * G * 8) {
            u32x4 ra[NR], rc[NR];
#pragma unroll
            for (int rr = 0; rr < NR; ++rr) {
                const int t = t0 + rr * G * 8; const bf16_t* orow = Ob + (size_t)(t < T ? t : t0) * DM + lane * 16;
                ra[rr] = *reinterpret_cast<const u32x4*>(orow); rc[rr] = *reinterpret_cast<const u32x4*>(orow + 8);
            }
#pragma unroll
            for (int rr = 0; rr < NR; ++rr) {
                const int t = t0 + rr * G * 8;
                float x[16];
#pragma unroll
                for (int e = 0; e < 4; ++e) { x[2 * e] = __uint_as_float(ra[rr][e] << 16); x[2 * e + 1] = __uint_as_float(ra[rr][e] & 0xffff0000u); x[8 + 2 * e] = __uint_as_float(rc[rr][e] << 16); x[8 + 2 * e + 1] = __uint_as_float(rc[rr][e] & 0xffff0000u); }
                float ss = 0.f;
#pragma unroll
                for (int e = 0; e < 16; ++e) ss += x[e] * x[e];
#pragma unroll
                for (int o = 16; o >= 1; o >>= 1) ss += __shfl_xor(ss, o);
                const float rstd = rsqrtf(ss * (1.0f / 512.0f) + EPS);
#pragma unroll
                for (int e = 0; e < 16; ++e) x[e] *= rstd;
                if (t < T) {
                    bf16_t* orow = Ob + (size_t)t * DM + lane * 16;
                    *reinterpret_cast<u32x4*>(orow) = (u32x4){cvtpk(x[0], x[1]), cvtpk(x[2], x[3]), cvtpk(x[4], x[5]), cvtpk(x[6], x[7])};
                    *reinterpret_cast<u32x4*>(orow + 8) = (u32x4){cvtpk(x[8], x[9]), cvtpk(x[10], x[11]), cvtpk(x[12], x[13]), cvtpk(x[14], x[15])};
                }
            }
        }
    }
    SEAM(6);

    if (IN(7)) {
        int pm, pn;
        for (int i = 0; tile_next(i, G, bx, NMT, 4, pm, pn); ++i) {
            f32x4 acc[2][2][4][2];
            const int brow = pm * 256, bcol = pn * 256;
            gemm_core<true>(lds, Ob, DM, Woutt, DM, 16, brow, bcol, acc);
            EPI_GEOM
            int b, S, tok0; tokinfo(brow, b, S, tok0);
            const float* g1 = mod + b * 6144 + 2048;
            const int cl = wc * 32 + fq * 4;
            f32x4 gv[2][2], xv[2][2][2];
#pragma unroll
            for (int bj = 0; bj < 2; ++bj)
#pragma unroll
                for (int n = 0; n < 2; ++n) gv[bj][n] = *reinterpret_cast<const f32x4*>(g1 + bcol + bj * 128 + n * 16 + cl);
            { const float* xr = xrow(xp, xs, brow + wr * 64 + fr);
#pragma unroll
              for (int bj = 0; bj < 2; ++bj)
#pragma unroll
                  for (int n = 0; n < 2; ++n) xv[0][bj][n] = *reinterpret_cast<const f32x4*>(xr + bcol + bj * 128 + n * 16 + cl); }
#pragma unroll
            for (int it = 0; it < 8; ++it) {
                const int ai = it >> 2, m = it & 3;
                if (it + 1 < 8) {
                    const float* xr = xrow(xp, xs, brow + ((it + 1) >> 2) * 128 + wr * 64 + ((it + 1) & 3) * 16 + fr);
#pragma unroll
                    for (int bj = 0; bj < 2; ++bj)
#pragma unroll
                        for (int n = 0; n < 2; ++n) xv[(it + 1) & 1][bj][n] = *reinterpret_cast<const f32x4*>(xr + bcol + bj * 128 + n * 16 + cl);
                }
                const int row = brow + ai * 128 + wr * 64 + m * 16 + fr;
#pragma unroll
                for (int bj = 0; bj < 2; ++bj)
#pragma unroll
                    for (int n = 0; n < 2; ++n)
                        *reinterpret_cast<f32x4*>(out + (size_t)row * DM + bcol + bj * 128 + n * 16 + cl) = xv[it & 1][bj][n] * ALPHA + gv[bj][n] * acc[ai][bj][m][n];
                asm volatile("" ::: "memory");
            }
        }
    }
    SEAM(7);

    if (IN(8)) {
        const float* l1g = p.in[16]; const float* l1b = p.in[17];
        constexpr int NR = 4;
        for (int t0 = bx * 8 + wv; t0 < T; t0 += NR * G * 8) {
            f32x4 v[NR][4];
#pragma unroll
            for (int rr = 0; rr < NR; ++rr) {
                const int t = t0 + rr * G * 8; const float* orow = out + (size_t)(t < T ? t : t0) * DM;
#pragma unroll
                for (int c = 0; c < 4; ++c) v[rr][c] = *reinterpret_cast<const f32x4*>(orow + c * 256 + lane * 4);
            }
#pragma unroll
            for (int rr = 0; rr < NR; ++rr) {
                const int t = t0 + rr * G * 8;
                float* orow = out + (size_t)t * DM;
                float s = 0.f;
#pragma unroll
                for (int c = 0; c < 4; ++c) s += (v[rr][c][0] + v[rr][c][1]) + (v[rr][c][2] + v[rr][c][3]);
                float mean = wave_sum(s) * (1.0f / 1024.0f);
                float q = 0.f;
#pragma unroll
                for (int c = 0; c < 4; ++c) { v[rr][c] = v[rr][c] - mean; q += (v[rr][c][0] * v[rr][c][0] + v[rr][c][1] * v[rr][c][1]) + (v[rr][c][2] * v[rr][c][2] + v[rr][c][3] * v[rr][c][3]); }
                float rstd = rsqrtf(wave_sum(q) * (1.0f / 1024.0f) + EPS);
                s = 0.f;
#pragma unroll
                for (int c = 0; c < 4; ++c) {
                    const int col = c * 256 + lane * 4;
                    v[rr][c] = v[rr][c] * rstd * *reinterpret_cast<const f32x4*>(l1g + col) + *reinterpret_cast<const f32x4*>(l1b + col);
                    if (t < T) *reinterpret_cast<f32x4*>(orow + col) = v[rr][c];
                    s += (v[rr][c][0] + v[rr][c][1]) + (v[rr][c][2] + v[rr][c][3]);
                }
                mean = wave_sum(s) * (1.0f / 1024.0f);
                q = 0.f;
#pragma unroll
                for (int c = 0; c < 4; ++c) { v[rr][c] = v[rr][c] - mean; q += (v[rr][c][0] * v[rr][c][0] + v[rr][c][1] * v[rr][c][1]) + (v[rr][c][2] * v[rr][c][2] + v[rr][c][3] * v[rr][c][3]); }
                rstd = rsqrtf(wave_sum(q) * (1.0f / 1024.0f) + EPS);
                if (t < T) {
                    int b, S, tok0; tokinfo(t, b, S, tok0);
                    const float* md = mod + b * 6144;
#pragma unroll
                    for (int c = 0; c < 4; ++c) {
                        const int col = c * 256 + lane * 4;
                        const f32x4 sh = *reinterpret_cast<const f32x4*>(md + 3072 + col), sc = *reinterpret_cast<const f32x4*>(md + 4096 + col);
                        const f32x4 y = v[rr][c] * rstd * (sc + 1.0f) + sh;
                        *reinterpret_cast<u32x2*>(U + (size_t)t * DM + col) = (u32x2){cvtpk(y[0], y[1]), cvtpk(y[2], y[3])};
                    }
                }
            }
        }
    }
    SEAM(8);

    if (IN(9)) {
        int pm, pn;
        for (int i = 0; tile_next(i, G, bx, NMT, 22, pm, pn); ++i) {
            f32x4 acc[2][2][4][2];
            const int brow = pm * 256, bcol = pn * 256;
            gemm_core<true>(lds, U, DM, Wgut, DM, 16, brow, bcol, acc);
            EPI_GEOM
#pragma unroll
            for (int ai = 0; ai < 2; ++ai)
#pragma unroll
                for (int m = 0; m < 4; ++m) {
                    asm volatile("" ::: "memory"); const int row = brow + ai * 128 + wr * 64 + m * 16 + fr;
#pragma unroll
                    for (int n = 0; n < 2; ++n) {
                        const int c0 = pn * 128 + wc * 32 + n * 16 + fq * 4; const f32x4 g = acc[ai][0][m][n], uu = acc[ai][1][m][n];
                        float f[4];
#pragma unroll
                        for (int j = 0; j < 4; ++j) {
                            const float e = __builtin_amdgcn_exp2f(-LOG2E * g[j]);
                            f[j] = g[j] * __builtin_amdgcn_rcpf(1.0f + e) * uu[j];
                        }
                        *reinterpret_cast<u32x2*>(F + (size_t)row * DFF + c0) = (u32x2){cvtpk(f[0], f[1]), cvtpk(f[2], f[3])};
                    }
                }
        }
    }
    SEAM(9);

    if (IN(10)) {
        int pm, pn;
        for (int i = 0; tile_next(i, G, bx, NMT, 4, pm, pn); ++i) {
            f32x4 acc[2][2][4][2];
            const int brow = pm * 256, bcol = pn * 256;
            gemm_core<true>(lds, F, DFF, Wdnt, DFF, 44, brow, bcol, acc);
            EPI_GEOM
            int b, S, tok0; tokinfo(brow, b, S, tok0);
            const float* g2 = mod + b * 6144 + 5120;
            const int cl = wc * 32 + fq * 4;
            f32x4 gv[2][2], xv[2][2][2];
#pragma unroll
            for (int bj = 0; bj < 2; ++bj)
#pragma unroll
                for (int n = 0; n < 2; ++n) gv[bj][n] = *reinterpret_cast<const f32x4*>(g2 + bcol + bj * 128 + n * 16 + cl);
            { const float* xr = out + (size_t)(brow + wr * 64 + fr) * DM;
#pragma unroll
              for (int bj = 0; bj < 2; ++bj)
#pragma unroll
                  for (int n = 0; n < 2; ++n) xv[0][bj][n] = *reinterpret_cast<const f32x4*>(xr + bcol + bj * 128 + n * 16 + cl); }
#pragma unroll
            for (int it = 0; it < 8; ++it) {
                const int ai = it >> 2, m = it & 3;
                if (it + 1 < 8) {
                    const float* xr = out + (size_t)(brow + ((it + 1) >> 2) * 128 + wr * 64 + ((it + 1) & 3) * 16 + fr) * DM;
#pragma unroll
                    for (int bj = 0; bj < 2; ++bj)
#pragma unroll
                        for (int n = 0; n < 2; ++n) xv[(it + 1) & 1][bj][n] = *reinterpret_cast<const f32x4*>(xr + bcol + bj * 128 + n * 16 + cl);
                }
                const int row = brow + ai * 128 + wr * 64 + m * 16 + fr;
#pragma unroll
                for (int bj = 0; bj < 2; ++bj)
#pragma unroll
                    for (int n = 0; n < 2; ++n)
                        *reinterpret_cast<f32x4*>(out + (size_t)row * DM + bcol + bj * 128 + n * 16 + cl) = xv[it & 1][bj][n] * ALPHA + gv[bj][n] * acc[ai][bj][m][n];
                asm volatile("" ::: "memory");
            }
        }
    }
    SEAM(10);

    if (IN(11)) {
        const float* l2g = p.in[21]; const float* l2b = p.in[22];
        constexpr int NR = 4;
        for (int t0 = bx * 8 + wv; t0 < T; t0 += NR * G * 8) {
            f32x4 v[NR][4];
#pragma unroll
            for (int rr = 0; rr < NR; ++rr) {
                const int t = t0 + rr * G * 8; const float* orow = out + (size_t)(t < T ? t : t0) * DM;
#pragma unroll
                for (int c = 0; c < 4; ++c) v[rr][c] = *reinterpret_cast<const f32x4*>(orow + c * 256 + lane * 4);
            }
#pragma unroll
            for (int rr = 0; rr < NR; ++rr) {
                const int t = t0 + rr * G * 8;
                float* orow = out + (size_t)t * DM;
                float s = 0.f;
#pragma unroll
                for (int c = 0; c < 4; ++c) s += (v[rr][c][0] + v[rr][c][1]) + (v[rr][c][2] + v[rr][c][3]);
                const float mean = wave_sum(s) * (1.0f / 1024.0f);
                float q = 0.f;
#pragma unroll
                for (int c = 0; c < 4; ++c) { v[rr][c] = v[rr][c] - mean; q += (v[rr][c][0] * v[rr][c][0] + v[rr][c][1] * v[rr][c][1]) + (v[rr][c][2] * v[rr][c][2] + v[rr][c][3] * v[rr][c][3]); }
                const float rstd = rsqrtf(wave_sum(q) * (1.0f / 1024.0f) + EPS);
                if (t < T) {
#pragma unroll
                    for (int c = 0; c < 4; ++c) {
                        const int col = c * 256 + lane * 4;
                        *reinterpret_cast<f32x4*>(orow + col) = v[rr][c] * rstd * *reinterpret_cast<const f32x4*>(l2g + col) + *reinterpret_cast<const f32x4*>(l2b + col);
                    }
                }
            }
        }
    }
#undef IN
#undef SEAM
}

extern "C" void kernel_launch(void* const* d_in, const int* in_sizes, int n_in, void* d_out, int out_size, void* d_ws, size_t ws_size, hipStream_t stream) {
    static int grid_blocks = 0;
    if (grid_blocks == 0) {
        if (n_in != 23 || out_size != T * DM || ws_size < WS_END) { fprintf(stderr, "kernel_launch: unexpected shapes (n_in %d out %d ws %zu)\n", n_in, out_size, ws_size); grid_blocks = -1; return; }
        int dev = 0, cus = 0, per_cu = 0;
        hipGetDevice(&dev);
        hipDeviceGetAttribute(&cus, hipDeviceAttributeMultiprocessorCount, dev);
        if (hipFuncSetAttribute((const void*)fwd_kernel, hipFuncAttributeMaxDynamicSharedMemorySize, LDS_BYTES) != hipSuccess) { fprintf(stderr, "kernel_launch: hipFuncSetAttribute failed\n"); grid_blocks = -1; return; }
        if (hipOccupancyMaxActiveBlocksPerMultiprocessor(&per_cu, (const void*)fwd_kernel, 512, LDS_BYTES) != hipSuccess || per_cu < 1) { fprintf(stderr, "kernel_launch: occupancy query says %d\n", per_cu); per_cu = 1; }
        (void)hipGetLastError();
        grid_blocks = cus;
    }
    if (grid_blocks < 0) return;
    if (hipMemsetAsync((char*)d_ws + WS_BAR, 0, XCD_BAR_WORDS * 4, stream) != hipSuccess) { fprintf(stderr, "kernel_launch: hipMemsetAsync failed\n"); return; }
    Params p{};
    for (int i = 0; i < 23; ++i) p.in[i] = (const float*)d_in[i];
    p.out = (float*)d_out; p.ws = (unsigned char*)d_ws; p.lo = 0; p.hi = NPHASE;
    void* args[] = {&p};
    hipError_t e = hipLaunchCooperativeKernel((const void*)fwd_kernel, dim3(grid_blocks), dim3(512), args, LDS_BYTES, stream);
    if (e != hipSuccess) fprintf(stderr, "kernel_launch: cooperative launch failed: %s (grid %d)\n", hipGetErrorString(e), grid_blocks);
}
```
